# Optimizing an MI355X kernel written in HIP

```python
import jax, jax.numpy as jnp
from jax import lax
import numpy as np

D_MODEL = 1024
BATCH = 4
SEQ = 4096
DEPTH = 1

HEAD_DIM = 64
MIX_WIDTH = D_MODEL
A_WIDTH = MIX_WIDTH // 2
B_WIDTH = MIX_WIDTH - A_WIDTH
A_HEADS = A_WIDTH // HEAD_DIM
B_Q_HEADS = B_WIDTH // HEAD_DIM
B_KV_HEADS = 2
B_KV_WIDTH = B_KV_HEADS * HEAD_DIM
IN_WIDTH = 3 * A_WIDTH + B_WIDTH + 2 * B_KV_WIDTH
A_CONFIGS = ((128, 1), (512, 4), (2048, 16))
A_BLOCK = 64
B_HALF_WINDOW = 128
B_BLOCK = 128
N_GROUPS = 4
EXPERTS_PER_GROUP = 8
N_EXPERTS = N_GROUPS * EXPERTS_PER_GROUP
TOP_K = 2
D_EXPERT = D_MODEL // 2
PLE_DIM = 256
EPS = 1e-6
NEG = -1e30

kernel_name = "hybrid_dilated_swa_hiermoe_encoder"


def rmsnorm(x, g):
    xf = x.astype(jnp.float32)
    r = lax.rsqrt(jnp.mean(xf * xf, axis=-1, keepdims=True) + EPS)
    return (xf * r).astype(x.dtype) * g


def alibi_slopes(n):
    return jnp.exp2(-8.0 * jnp.arange(1, n + 1, dtype=jnp.float32) / n)


def banded_attention(q, k, v, half, blk, slopes, dist_scale, sink=None):
    n, l, hk, g, dh = q.shape
    nb = -(-l // blk)
    lp = nb * blk
    q = jnp.pad(q, ((0, 0), (0, lp - l), (0, 0), (0, 0), (0, 0)))
    pad_kv = ((0, 0), (blk, lp - l + blk), (0, 0), (0, 0))
    kb = jnp.pad(k, pad_kv).reshape(n, nb + 2, blk, hk, dh)
    vb = jnp.pad(v, pad_kv).reshape(n, nb + 2, blk, hk, dh)
    kw = jnp.concatenate([kb[:, :-2], kb[:, 1:-1], kb[:, 2:]], axis=2)
    vw = jnp.concatenate([vb[:, :-2], vb[:, 1:-1], vb[:, 2:]], axis=2)
    qb = q.reshape(n, nb, blk, hk, g, dh)
    s = jnp.einsum('nbqhgd,nbkhd->nbhgqk', qb, kw,
                   preferred_element_type=jnp.float32) * (dh ** -0.5)
    qpos = jnp.arange(lp).reshape(nb, blk)
    kpos = (jnp.arange(nb)[:, None] - 1) * blk + jnp.arange(3 * blk)[None, :]
    rel = kpos[:, None, :] - qpos[:, :, None]
    valid = (jnp.abs(rel) <= half) & (kpos[:, None, :] >= 0) & (kpos[:, None, :] < l)
    dist = jnp.abs(rel).astype(jnp.float32) * dist_scale
    s = s - slopes.astype(jnp.float32)[:, :, None, None] * dist[None, :, None, None]
    s = jnp.where(valid[None, :, None, None], s, NEG)
    m = jnp.max(s, axis=-1)
    if sink is not None:
        sk = sink.astype(jnp.float32)[:, :, None]
        m = jnp.maximum(m, sk)
    pexp = jnp.exp(s - m[..., None])
    den = jnp.sum(pexp, axis=-1)
    if sink is not None:
        den = den + jnp.exp(sk - m)
    o = jnp.einsum('nbhgqk,nbkhd->nbqhgd', pexp.astype(v.dtype), vw,
                   preferred_element_type=jnp.float32)
    o = o / den.transpose(0, 1, 4, 2, 3)[..., None]
    o = o.reshape(n, lp, hk, g, dh)[:, :l]
    lse = (m + jnp.log(den)).transpose(0, 1, 4, 2, 3).reshape(n, lp, hk, g)[:, :l]
    return o.astype(q.dtype), lse


def dilated_attention(q, k, v, slopes):
    b, s, h, dh = q.shape
    outs, lses = [], []
    for window, dil in A_CONFIGS:
        l = s // dil

        def to_sub(t):
            return t.reshape(b, l, dil, h, dh).transpose(0, 2, 1, 3, 4).reshape(b * dil, l, h, dh)

        o, lse = banded_attention(to_sub(q)[:, :, :, None], to_sub(k), to_sub(v),
                                  window // (2 * dil), A_BLOCK, slopes[:, None], float(dil))
        o = o[:, :, :, 0].reshape(b, dil, l, h, dh).transpose(0, 2, 1, 3, 4).reshape(b, s, h, dh)
        lse = lse[..., 0].reshape(b, dil, l, h).transpose(0, 2, 1, 3).reshape(b, s, h)
        outs.append(o)
        lses.append(lse)
    w = jax.nn.softmax(jnp.stack(lses, axis=0), axis=0)
    o = jnp.einsum('cbsh,cbshd->bshd', w, jnp.stack(outs, axis=0).astype(jnp.float32))
    return o.astype(q.dtype)


def windowed_gqa_sink(q, k, v, sink):
    b, s, hq, dh = q.shape
    g = hq // B_KV_HEADS
    qg = q.reshape(b, s, B_KV_HEADS, g, dh)
    slopes = alibi_slopes(hq).reshape(B_KV_HEADS, g)
    o, _ = banded_attention(qg, k, v, B_HALF_WINDOW, B_BLOCK, slopes, 1.0,
                            sink.reshape(B_KV_HEADS, g))
    return o.reshape(b, s, hq * dh)


def hier_moe(h, w_rg, b_rg, w_re, b_re, w_gate, w_up, w_down):
    b, s, d = h.shape
    t = h.reshape(b * s, d)
    n_tok = t.shape[0]
    glog = (t @ w_rg).astype(jnp.float32) + b_rg.astype(jnp.float32)
    gsel = jnp.argmax(glog, axis=-1)
    gw = jnp.max(jax.nn.softmax(glog, axis=-1), axis=-1)
    elog = ((t @ w_re).astype(jnp.float32) + b_re.astype(jnp.float32)).reshape(
        n_tok, N_GROUPS, EXPERTS_PER_GROUP)
    elog_sel = elog[jnp.arange(n_tok), gsel]
    top_v, top_i = lax.top_k(elog_sel, TOP_K)
    top_w = jax.nn.softmax(top_v, axis=-1) * gw[:, None]
    eid = gsel[:, None] * EXPERTS_PER_GROUP + top_i
    dense_w = jnp.sum(jax.nn.one_hot(eid, N_EXPERTS, dtype=jnp.float32) * top_w[..., None], axis=1)
    out = jnp.zeros((n_tok, d), jnp.float32)
    for grp in range(N_GROUPS):
        sl = slice(grp * EXPERTS_PER_GROUP, (grp + 1) * EXPERTS_PER_GROUP)
        a = jnp.einsum('td,edf->tef', t, w_gate[sl])
        u = jnp.einsum('td,edf->tef', t, w_up[sl])
        hid = jax.nn.silu(a) * u * dense_w[:, sl, None].astype(t.dtype)
        out = out + jnp.einsum('tef,efd->td', hid, w_down[sl], preferred_element_type=jnp.float32)
    return out.astype(h.dtype).reshape(b, s, d)


def setup_inputs(seed: int = 0) -> dict:
    key = jax.random.key(seed)
    ks = jax.random.split(key, 20)
    f32 = jnp.float32

    def nrm(k, shape, scale):
        return jax.random.normal(k, shape, f32) * scale

    def gain(k, shape):
        return 1.0 + 0.05 * jax.random.normal(k, shape, f32)

    return {
        "x": nrm(ks[0], (BATCH, SEQ, D_MODEL), 1.0),
        "p": nrm(ks[1], (DEPTH, BATCH, SEQ, PLE_DIM), 1.0),
        "g_mix": gain(ks[2], (DEPTH, D_MODEL)),
        "w_in": nrm(ks[3], (DEPTH, D_MODEL, IN_WIDTH), D_MODEL ** -0.5),
        "sink": nrm(ks[4], (DEPTH, B_Q_HEADS), 0.5),
        "g_grp_a": gain(ks[5], (DEPTH, A_WIDTH)),
        "g_grp_b": gain(ks[6], (DEPTH, B_WIDTH)),
        "w_out": nrm(ks[7], (DEPTH, MIX_WIDTH, D_MODEL), MIX_WIDTH ** -0.5),
        "g_ffn": gain(ks[8], (DEPTH, D_MODEL)),
        "w_router_group": nrm(ks[9], (DEPTH, D_MODEL, N_GROUPS), D_MODEL ** -0.5),
        "b_router_group": nrm(ks[10], (DEPTH, N_GROUPS), 0.01),
        "w_router_expert": nrm(ks[11], (DEPTH, D_MODEL, N_EXPERTS), D_MODEL ** -0.5),
        "b_router_expert": nrm(ks[12], (DEPTH, N_EXPERTS), 0.01),
        "w_expert_gate": nrm(ks[13], (DEPTH, N_EXPERTS, D_MODEL, D_EXPERT), D_MODEL ** -0.5),
        "w_expert_up": nrm(ks[14], (DEPTH, N_EXPERTS, D_MODEL, D_EXPERT), D_MODEL ** -0.5),
        "w_expert_down": nrm(ks[15], (DEPTH, N_EXPERTS, D_EXPERT, D_MODEL), D_EXPERT ** -0.5),
        "g_ple": gain(ks[16], (DEPTH, D_MODEL)),
        "w_ple_gate": nrm(ks[17], (DEPTH, D_MODEL, D_MODEL), D_MODEL ** -0.5),
        "w_ple_proj": nrm(ks[18], (DEPTH, PLE_DIM, D_MODEL), PLE_DIM ** -0.5),
        "g_final": gain(ks[19], (D_MODEL,)),
    }


def reference(x, p, g_mix, w_in, sink, g_grp_a, g_grp_b, w_out, g_ffn,
              w_router_group, b_router_group, w_router_expert, b_router_expert,
              w_expert_gate, w_expert_up, w_expert_down, g_ple, w_ple_gate, w_ple_proj,
              g_final):
    b, s, _ = x.shape
    split_at = [A_WIDTH, 2 * A_WIDTH, 3 * A_WIDTH, 3 * A_WIDTH + B_WIDTH,
                3 * A_WIDTH + B_WIDTH + B_KV_WIDTH]
    slopes_a = alibi_slopes(A_HEADS)
    for i in range(DEPTH):
        h = rmsnorm(x, g_mix[i])
        proj = h @ w_in[i]
        qa, ka, va, qb, kb, vb = jnp.split(proj, split_at, axis=-1)
        oa = dilated_attention(qa.reshape(b, s, A_HEADS, HEAD_DIM),
                               ka.reshape(b, s, A_HEADS, HEAD_DIM),
                               va.reshape(b, s, A_HEADS, HEAD_DIM), slopes_a).reshape(b, s, A_WIDTH)
        ob = windowed_gqa_sink(qb.reshape(b, s, B_Q_HEADS, HEAD_DIM),
                               kb.reshape(b, s, B_KV_HEADS, HEAD_DIM),
                               vb.reshape(b, s, B_KV_HEADS, HEAD_DIM), sink[i])
        mix = jnp.concatenate([rmsnorm(oa, g_grp_a[i]), rmsnorm(ob, g_grp_b[i])], axis=-1)
        x = x + mix @ w_out[i]
        h = rmsnorm(x, g_ffn[i])
        x = x + hier_moe(h, w_router_group[i], b_router_group[i], w_router_expert[i],
                         b_router_expert[i], w_expert_gate[i], w_expert_up[i], w_expert_down[i])
        gate = jax.nn.sigmoid(rmsnorm(x, g_ple[i]) @ w_ple_gate[i])
        x = x + (p[i] @ w_ple_proj[i]) * gate
    return rmsnorm(x, g_final)
```

```cpp
#include <hip/hip_runtime.h>
#include <cstdio>
#include <cstdint>

namespace nv {
constexpr int T = 16384, S = 4096, D = 1024, INW = 2304;
constexpr float EPS = 1e-6f;

__device__ __forceinline__ float wave_sum(float v) {
#pragma unroll
    for (int o = 1; o < 64; o <<= 1) v += __shfl_xor(v, o);
    return v;
}
__device__ __forceinline__ float wave_max(float v) {
#pragma unroll
    for (int o = 1; o < 64; o <<= 1) v = fmaxf(v, __shfl_xor(v, o));
    return v;
}
__device__ __forceinline__ float block_sum256(float v, float* red) {
    v = wave_sum(v);
    __syncthreads();
    if ((threadIdx.x & 63) == 0) red[threadIdx.x >> 6] = v;
    __syncthreads();
    return red[0] + red[1] + red[2] + red[3];
}

__global__ void __launch_bounds__(256) k_qkv(const float* x, const float* g, const float* w, float* proj) {
    __shared__ float h[4][D];
    __shared__ float red[4];
    const int t0 = blockIdx.x * 4, tid = threadIdx.x;
    for (int t = 0; t < 4; ++t) {
        float ss = 0.f;
        for (int k = tid; k < D; k += 256) { float v = x[(size_t)(t0 + t) * D + k]; h[t][k] = v; ss += v * v; }
        ss = block_sum256(ss, red);
        const float r = rsqrtf(ss / D + EPS);
        for (int k = tid; k < D; k += 256) h[t][k] = h[t][k] * r * g[k];
    }
    __syncthreads();
    float acc[4][9];
    for (int t = 0; t < 4; ++t) for (int j = 0; j < 9; ++j) acc[t][j] = 0.f;
    for (int k = 0; k < D; ++k) {
        float wv[9];
#pragma unroll
        for (int j = 0; j < 9; ++j) wv[j] = w[(size_t)k * INW + tid + 256 * j];
#pragma unroll
        for (int t = 0; t < 4; ++t) { const float hv = h[t][k];
#pragma unroll
            for (int j = 0; j < 9; ++j) acc[t][j] += hv * wv[j]; }
    }
    for (int t = 0; t < 4; ++t) for (int j = 0; j < 9; ++j) proj[(size_t)(t0 + t) * INW + tid + 256 * j] = acc[t][j];
}

__global__ void __launch_bounds__(64) k_attn_a(const float* proj, float* o) {
    __shared__ float sc[3 * 129 + 3];
    __shared__ float qs[64];
    const int tok = blockIdx.x >> 3, hd = blockIdx.x & 7, lane = threadIdx.x;
    const int b = tok / S, t = tok % S;
    const float slope = exp2f(-(float)(hd + 1));
    qs[lane] = proj[(size_t)tok * INW + hd * 64 + lane];
    __syncthreads();
    const int dil[3] = {1, 4, 16};
    float mx = -1e30f;
    for (int c = 0; c < 3; ++c) {
        for (int j = lane; j < 129; j += 64) {
            const int dl = j - 64, tk = t + dl * dil[c];
            float s = -1e30f;
            if (tk >= 0 && tk < S) {
                const float* kr = proj + (size_t)(b * S + tk) * INW + 512 + hd * 64;
                float a = 0.f;
                for (int d = 0; d < 64; ++d) a += qs[d] * kr[d];
                s = a * 0.125f - slope * (float)(abs(dl) * dil[c]);
            }
            sc[c * 129 + j] = s;
            mx = fmaxf(mx, s);
        }
    }
    mx = wave_max(mx);
    __syncthreads();
    float den = 0.f;
    for (int j = lane; j < 3 * 129; j += 64) { const float s = sc[j]; const float p = (s > -1e29f) ? expf(s - mx) : 0.f; sc[j] = p; den += p; }
    den = wave_sum(den);
    __syncthreads();
    float acc = 0.f;
    for (int c = 0; c < 3; ++c)
        for (int j = 0; j < 129; ++j) {
            const float p = sc[c * 129 + j];
            if (p != 0.f) { const int tk = t + (j - 64) * dil[c]; acc += p * proj[(size_t)(b * S + tk) * INW + 1024 + hd * 64 + lane]; }
        }
    o[(size_t)tok * D + hd * 64 + lane] = acc / den;
}

__global__ void __launch_bounds__(64) k_attn_b(const float* proj, const float* sink, float* o) {
    __shared__ float sc[257 + 3];
    __shared__ float qs[64];
    const int tok = blockIdx.x >> 3, hq = blockIdx.x & 7, hk = hq >> 2, lane = threadIdx.x;
    const int b = tok / S, t = tok % S;
    const float slope = exp2f(-(float)(hq + 1));
    qs[lane] = proj[(size_t)tok * INW + 1536 + hq * 64 + lane];
    __syncthreads();
    float mx = -1e30f;
    for (int j = lane; j < 257; j += 64) {
        const int dl = j - 128, tk = t + dl;
        float s = -1e30f;
        if (tk >= 0 && tk < S) {
            const float* kr = proj + (size_t)(b * S + tk) * INW + 2048 + hk * 64;
            float a = 0.f;
            for (int d = 0; d < 64; ++d) a += qs[d] * kr[d];
            s = a * 0.125f - slope * (float)abs(dl);
        }
        sc[j] = s;
        mx = fmaxf(mx, s);
    }
    mx = wave_max(mx);
    const float sk = sink[hq];
    mx = fmaxf(mx, sk);
    __syncthreads();
    float den = 0.f;
    for (int j = lane; j < 257; j += 64) { const float s = sc[j]; const float p = (s > -1e29f) ? expf(s - mx) : 0.f; sc[j] = p; den += p; }
    den = wave_sum(den) + expf(sk - mx);
    __syncthreads();
    float acc = 0.f;
    for (int j = 0; j < 257; ++j) {
        const float p = sc[j];
        if (p != 0.f) { const int tk = t + (j - 128); acc += p * proj[(size_t)(b * S + tk) * INW + 2176 + hk * 64 + lane]; }
    }
    o[(size_t)tok * D + 512 + hq * 64 + lane] = acc / den;
}

__global__ void __launch_bounds__(256) k_wout(const float* x, const float* o, const float* ga, const float* gb, const float* w, float* x1) {
    __shared__ float h[4][D];
    __shared__ float red[4];
    const int t0 = blockIdx.x * 4, tid = threadIdx.x;
    for (int t = 0; t < 4; ++t) {
        float sa = 0.f, sb = 0.f;
        for (int k = tid; k < 512; k += 256) { float v = o[(size_t)(t0 + t) * D + k]; h[t][k] = v; sa += v * v; float u = o[(size_t)(t0 + t) * D + 512 + k]; h[t][512 + k] = u; sb += u * u; }
        sa = block_sum256(sa, red); sb = block_sum256(sb, red);
        const float ra = rsqrtf(sa / 512 + EPS), rb = rsqrtf(sb / 512 + EPS);
        for (int k = tid; k < 512; k += 256) { h[t][k] = h[t][k] * ra * ga[k]; h[t][512 + k] = h[t][512 + k] * rb * gb[k]; }
    }
    __syncthreads();
    float acc[4][4];
    for (int t = 0; t < 4; ++t) for (int j = 0; j < 4; ++j) acc[t][j] = 0.f;
    for (int k = 0; k < D; ++k) {
        float wv[4];
#pragma unroll
        for (int j = 0; j < 4; ++j) wv[j] = w[(size_t)k * D + tid + 256 * j];
#pragma unroll
        for (int t = 0; t < 4; ++t) { const float hv = h[t][k];
#pragma unroll
            for (int j = 0; j < 4; ++j) acc[t][j] += hv * wv[j]; }
    }
    for (int t = 0; t < 4; ++t) for (int j = 0; j < 4; ++j) { const size_t i = (size_t)(t0 + t) * D + tid + 256 * j; x1[i] = x[i] + acc[t][j]; }
}

__global__ void __launch_bounds__(256) k_moe(float* x1, const float* g, const float* wrg, const float* brg, const float* wre, const float* bre,
                                            const float* wg, const float* wu, const float* wd) {
    __shared__ float h[D];
    __shared__ float hid[512];
    __shared__ float lg[36];
    __shared__ float red[4];
    __shared__ int sel[2];
    __shared__ float selw[2];
    const int tok = blockIdx.x, tid = threadIdx.x;
    float ss = 0.f;
    for (int k = tid; k < D; k += 256) { float v = x1[(size_t)tok * D + k]; h[k] = v; ss += v * v; }
    ss = block_sum256(ss, red);
    const float r = rsqrtf(ss / D + EPS);
    for (int k = tid; k < D; k += 256) h[k] = h[k] * r * g[k];
    __syncthreads();
    if (tid < 36) {
        float a = 0.f;
        if (tid < 4) { for (int k = 0; k < D; ++k) a += h[k] * wrg[k * 4 + tid]; a += brg[tid]; }
        else { const int e = tid - 4; for (int k = 0; k < D; ++k) a += h[k] * wre[k * 32 + e]; a += bre[e]; }
        lg[tid] = a;
    }
    __syncthreads();
    if (tid == 0) {
        int gs = 0; float gm = lg[0];
        for (int i = 1; i < 4; ++i) if (lg[i] > gm) { gm = lg[i]; gs = i; }
        float den = 0.f; for (int i = 0; i < 4; ++i) den += expf(lg[i] - gm);
        const float gw = 1.f / den;
        const float* el = lg + 4 + gs * 8;
        int i0 = 0; for (int i = 1; i < 8; ++i) if (el[i] > el[i0]) i0 = i;
        int i1 = (i0 == 0) ? 1 : 0; for (int i = 0; i < 8; ++i) if (i != i0 && el[i] > el[i1]) i1 = i;
        const float e1 = expf(el[i1] - el[i0]);
        sel[0] = gs * 8 + i0; sel[1] = gs * 8 + i1;
        selw[0] = gw / (1.f + e1); selw[1] = gw * e1 / (1.f + e1);
    }
    __syncthreads();
    float out[4] = {0.f, 0.f, 0.f, 0.f};
    for (int s = 0; s < 2; ++s) {
        const int e = sel[s]; const float wgt = selw[s];
        const float* Wg = wg + (size_t)e * D * 512; const float* Wu = wu + (size_t)e * D * 512; const float* Wd = wd + (size_t)e * 512 * D;
        float a0 = 0.f, a1 = 0.f, u0 = 0.f, u1 = 0.f;
        for (int k = 0; k < D; ++k) { const float hv = h[k]; a0 += hv * Wg[(size_t)k * 512 + tid]; a1 += hv * Wg[(size_t)k * 512 + 256 + tid]; u0 += hv * Wu[(size_t)k * 512 + tid]; u1 += hv * Wu[(size_t)k * 512 + 256 + tid]; }
        __syncthreads();
        hid[tid] = (a0 / (1.f + expf(-a0))) * u0 * wgt;
        hid[256 + tid] = (a1 / (1.f + expf(-a1))) * u1 * wgt;
        __syncthreads();
        for (int f = 0; f < 512; ++f) { const float hv = hid[f];
#pragma unroll
            for (int j = 0; j < 4; ++j) out[j] += hv * Wd[(size_t)f * D + tid + 256 * j]; }
    }
    for (int j = 0; j < 4; ++j) x1[(size_t)tok * D + tid + 256 * j] += out[j];
}

__global__ void __launch_bounds__(256) k_ple(float* xo, const float* p, const float* gp, const float* wpg, const float* wpp, const float* gf) {
    __shared__ float h[4][D];
    __shared__ float ps[4][256];
    __shared__ float red[4];
    const int t0 = blockIdx.x * 4, tid = threadIdx.x;
    for (int t = 0; t < 4; ++t) {
        float ss = 0.f;
        for (int k = tid; k < D; k += 256) { float v = xo[(size_t)(t0 + t) * D + k]; h[t][k] = v; ss += v * v; }
        ss = block_sum256(ss, red);
        const float r = rsqrtf(ss / D + EPS);
        for (int k = tid; k < D; k += 256) h[t][k] = h[t][k] * r * gp[k];
        ps[t][tid] = p[(size_t)(t0 + t) * 256 + tid];
    }
    __syncthreads();
    float acc[4][4], pp[4][4];
    for (int t = 0; t < 4; ++t) for (int j = 0; j < 4; ++j) { acc[t][j] = 0.f; pp[t][j] = 0.f; }
    for (int k = 0; k < D; ++k) {
        float wv[4];
#pragma unroll
        for (int j = 0; j < 4; ++j) wv[j] = wpg[(size_t)k * D + tid + 256 * j];
#pragma unroll
        for (int t = 0; t < 4; ++t) { const float hv = h[t][k];
#pragma unroll
            for (int j = 0; j < 4; ++j) acc[t][j] += hv * wv[j]; }
    }
    for (int k = 0; k < 256; ++k) {
        float wv[4];
#pragma unroll
        for (int j = 0; j < 4; ++j) wv[j] = wpp[(size_t)k * D + tid + 256 * j];
#pragma unroll
        for (int t = 0; t < 4; ++t) { const float hv = ps[t][k];
#pragma unroll
            for (int j = 0; j < 4; ++j) pp[t][j] += hv * wv[j]; }
    }
    for (int t = 0; t < 4; ++t) {
        float v[4]; float ss = 0.f;
        for (int j = 0; j < 4; ++j) { const size_t i = (size_t)(t0 + t) * D + tid + 256 * j; const float gate = 1.f / (1.f + expf(-acc[t][j])); v[j] = xo[i] + pp[t][j] * gate; ss += v[j] * v[j]; }
        ss = block_sum256(ss, red);
        const float r = rsqrtf(ss / D + EPS);
        for (int j = 0; j < 4; ++j) { const size_t i = (size_t)(t0 + t) * D + tid + 256 * j; xo[i] = v[j] * r * gf[tid + 256 * j]; }
    }
}
}

extern "C" void kernel_launch(void* const* d_in, const int* in_sizes, int n_in, void* d_out, int out_size, void* d_ws, size_t ws_size, hipStream_t stream) {
    using namespace nv;
    const float* x = (const float*)d_in[0]; const float* p = (const float*)d_in[1]; const float* g_mix = (const float*)d_in[2]; const float* w_in = (const float*)d_in[3];
    const float* sink = (const float*)d_in[4]; const float* ga = (const float*)d_in[5]; const float* gb = (const float*)d_in[6]; const float* w_out = (const float*)d_in[7];
    const float* g_ffn = (const float*)d_in[8]; const float* wrg = (const float*)d_in[9]; const float* brg = (const float*)d_in[10]; const float* wre = (const float*)d_in[11];
    const float* bre = (const float*)d_in[12]; const float* wg = (const float*)d_in[13]; const float* wu = (const float*)d_in[14]; const float* wd = (const float*)d_in[15];
    const float* g_ple = (const float*)d_in[16]; const float* wpg = (const float*)d_in[17]; const float* wpp = (const float*)d_in[18]; const float* g_fin = (const float*)d_in[19];
    float* out = (float*)d_out;
    const size_t need = (size_t)T * INW * 4 + (size_t)T * D * 4;
    if (ws_size < need) { fprintf(stderr, "kernel_launch: ws too small: %zu < %zu\n", ws_size, need); return; }
    float* proj = (float*)d_ws; float* o = proj + (size_t)T * INW;
    k_qkv<<<T / 4, 256, 0, stream>>>(x, g_mix, w_in, proj);
    k_attn_a<<<T * 8, 64, 0, stream>>>(proj, o);
    k_attn_b<<<T * 8, 64, 0, stream>>>(proj, sink, o);
    k_wout<<<T / 4, 256, 0, stream>>>(x, o, ga, gb, w_out, out);
    k_moe<<<T, 256, 0, stream>>>(out, g_ffn, wrg, brg, wre, bre, wg, wu, wd);
    k_ple<<<T / 4, 256, 0, stream>>>(out, p, g_ple, wpg, wpp, g_fin);
}
```

```cpp
#include <hip/hip_runtime.h>
#include <cstdio>
#include <cstdint>

#define LAS __attribute__((address_space(3)))
#define GAS __attribute__((address_space(1)))
typedef _Float16 h16;
typedef _Float16 h16x2 __attribute__((ext_vector_type(2)));
typedef _Float16 h16x4 __attribute__((ext_vector_type(4)));
typedef _Float16 h16x8 __attribute__((ext_vector_type(8)));
typedef float f32x2 __attribute__((ext_vector_type(2)));
typedef float f32x4 __attribute__((ext_vector_type(4)));
typedef float f32x16 __attribute__((ext_vector_type(16)));
typedef unsigned u32x2 __attribute__((ext_vector_type(2)));
typedef unsigned u32x4 __attribute__((ext_vector_type(4)));
typedef short v4i16_t __attribute__((ext_vector_type(4)));
typedef short s16x8 __attribute__((ext_vector_type(8)));
typedef GAS unsigned gu32;

#ifndef MK_N_LAUNCHES
#define MK_N_LAUNCHES 1
#endif

constexpr int T = 16384, SEQ = 4096, DM = 1024, INW = 2304, NE = 32, DE = 512, PLE = 256;
constexpr float EPS = 1e-6f;
constexpr float LOG2E = 1.4426950408889634f;
constexpr float QSCALE = 0.125f * LOG2E;

constexpr size_t MiB = 1u << 20;
constexpr size_t WS_CTL = 0, CTL_ZERO_BYTES = 1 * MiB;
constexpr size_t WS_WIN = 1 * MiB;
constexpr size_t WS_WOUT = 6 * MiB;
constexpr size_t WS_WR = 8 * MiB;
constexpr size_t WS_WPG = 9 * MiB;
constexpr size_t WS_WPP = 11 * MiB;
constexpr size_t WS_WD = 12 * MiB;
constexpr size_t WS_WGU = 44 * MiB;
constexpr size_t WS_Y = 44 * MiB;
constexpr size_t WS_PROJ = 108 * MiB;
constexpr size_t WS_XMH = 108 * MiB;
constexpr size_t WS_X2H = 108 * MiB;
constexpr size_t WS_HID = 140 * MiB;
constexpr size_t WS_XH = 180 * MiB;
constexpr size_t WS_O = 180 * MiB;
constexpr size_t WS_PPROJ = 212 * MiB;
constexpr size_t WS_PH = 244 * MiB;
constexpr size_t WS_ROWSS0 = 252 * MiB;
constexpr size_t WS_HEADSS = 253 * MiB;
constexpr size_t WS_LSEC = 254 * MiB;
constexpr size_t WS_XSS = 256 * MiB;
constexpr size_t WS_LIST = 257 * MiB;
constexpr size_t WS_RSW = 259 * MiB;
constexpr size_t WS_ROWSS3 = 263 * MiB;
constexpr size_t WS_XSS3 = 264 * MiB;
constexpr size_t WS_END = 266 * MiB;

constexpr int CW_CNT = 1024;
constexpr int CW_BAR = 4096;

constexpr int RING_BYTES = 131072;
constexpr int LDSCTL_OFF = RING_BYTES;
constexpr int MISC_OFF = LDSCTL_OFF + 64;
constexpr int MOE_GT_OFF = LDSCTL_OFF + 256;
constexpr int MOE_CN_OFF = MOE_GT_OFF + 256;
constexpr int LDS_BYTES = 147456;

__device__ __forceinline__ unsigned pk2(float lo, float hi) { h16x2 v = {(h16)lo, (h16)hi}; return __builtin_bit_cast(unsigned, v); }
__device__ __forceinline__ float wave_sum(float v) {
#pragma unroll
    for (int o = 1; o < 64; o <<= 1) v += __shfl_xor(v, o);
    return v;
}
__device__ __forceinline__ float xhalf_max(float v) { auto rr = __builtin_amdgcn_permlane32_swap(__float_as_uint(v), __float_as_uint(v), false, false); return fmaxf(__uint_as_float(rr[0]), __uint_as_float(rr[1])); }
__device__ __forceinline__ float xhalf_sum(float v) { auto rr = __builtin_amdgcn_permlane32_swap(__float_as_uint(v), __float_as_uint(v), false, false); return __uint_as_float(rr[0]) + __uint_as_float(rr[1]); }
#define LDS_WAIT() asm volatile("s_waitcnt lgkmcnt(0)" ::: "memory")
#define VM_WAIT() asm volatile("s_waitcnt vmcnt(0)" ::: "memory")
#define RLX_AGENT __ATOMIC_RELAXED, __HIP_MEMORY_SCOPE_AGENT

namespace g8 {
constexpr int BM = 256, BK = 64, HALF = 128, HTB = HALF * BK * 2, STAGE_BYTES = 8 * HTB, NXCD = 8, WGM = 8;
__host__ __device__ __forceinline__ int lds_byte(int r, int c) { const int st = (r >> 4) * 2 + (c >> 5), rr = r & 15, cc = c & 31, ob = rr * 64 + cc * 2; return st * 1024 + (ob ^ (((ob >> 9) & 1) << 5)); }
__host__ __device__ __forceinline__ void stage_rc(int b, int& R, int& C) { const int st = b / 1024, sb = b % 1024, swz = sb ^ (((sb >> 9) & 1) << 5); R = (st >> 1) * 16 + swz / 64; C = (st & 1) * 32 + (swz % 64) / 2; }
__host__ __device__ __forceinline__ int perm32(int rho) { const int n = rho >> 4, i = rho & 15; return 8 * (i >> 2) + 4 * n + (i & 3); }

struct Unit { int a, b, c, d; };

struct StaticOrder {
    int nM, nN, nwg, G, c;
    __device__ void init(int M, int N, int G_, int c_) { nM = M / BM; nN = N / BM; nwg = nM * nN; G = G_; c = c_; }
    __device__ bool next(int i, Unit& u) const {
        const long L = (long)i * G + c; if (L >= nwg) return false;
        int wgid = (int)L; { const int q = nwg / NXCD, r = nwg % NXCD, xcd = wgid % NXCD, off = wgid / NXCD; wgid = (xcd < r ? xcd * (q + 1) : r * (q + 1) + (xcd - r) * q) + off; }
        const int nig = WGM * nN, gid = wgid / nig, fm = gid * WGM, gsz = (nM - fm) < WGM ? (nM - fm) : WGM;
        u.a = fm + ((wgid % nig) % gsz); u.b = (wgid % nig) / gsz; u.c = 0; u.d = 0; return true;
    }
};
struct MoeOrder {
    int G, vcu; const LAS int* gt;
    __device__ bool next(int i, Unit& u) const {
        const int L = i * G + vcu; const int total = gt[32] * 4; if (L >= total) return false;
        const int rt = L >> 2; int e = 0;
#pragma unroll 1
        for (int j = 1; j < 32; ++j) e += (gt[j] <= rt) ? 1 : 0;
        u.a = rt - gt[e]; u.b = L & 3; u.c = e; u.d = rt; return true;
    }
};

template <class Prob, class Epi, class Sched, bool ALIGN_EPI>
__device__ __forceinline__ void gemm_phase(LAS unsigned char* lds, const Prob& P, const Sched& S, const Epi& E) {
    const int tid = threadIdx.x, wid = __builtin_amdgcn_readfirstlane(tid >> 6), lane = tid & 63, wr = wid >> 2, wc = wid & 3, fr = lane & 15, fq = lane >> 4;
    const int K = P.K, nt = K / BK;
    unsigned voffB[2];
#pragma unroll
    for (int i = 0; i < 2; ++i) { int R, C; stage_rc(tid * 16 + i * 8192, R, C); const int Rb = (R & ~31) + perm32(R & 31); voffB[i] = (unsigned)(Rb * K + C) * 2u; }
    const size_t kstep = (size_t)(BK * 2);
    const size_t hstepB = (size_t)HALF * K * 2;
    const unsigned ldsw = (unsigned)wid * 1024u;
    const int aoff = lds_byte(wr * 64 + fr, fq * 8), boff = lds_byte(wc * 32 + fr, fq * 8);
#define G8_SA(b, h) (((b) * 2 + (h)) * HTB)
#define G8_SB(b, h) ((4 + (b) * 2 + (h)) * HTB)
#define G8_STAGE(bufoff, gbase, voff) do { _Pragma("unroll") for (int _i = 0; _i < 2; ++_i) \
        __builtin_amdgcn_global_load_lds((const unsigned*)((const char*)(gbase) + (voff)[_i]), (LAS unsigned*)(lds + (bufoff) + ldsw + _i * 8192), 16, 0, 0); } while (0)
#define G8_LDA(dst, b, h) do { _Pragma("unroll") for (int m = 0; m < 4; ++m) _Pragma("unroll") for (int k = 0; k < 2; ++k) dst[m][k] = *(const LAS h16x8*)(lds + G8_SA(b, h) + aoff + m * 2048 + k * 1024); } while (0)
#define G8_LDB(dst, b, h) do { _Pragma("unroll") for (int n = 0; n < 2; ++n) _Pragma("unroll") for (int k = 0; k < 2; ++k) dst[n][k] = *(const LAS h16x8*)(lds + G8_SB(b, h) + boff + n * 2048 + k * 1024); } while (0)
#define G8_MMA(ai, bj, At, Bt) do { __builtin_amdgcn_s_setprio(1); _Pragma("unroll") for (int m = 0; m < 4; ++m) _Pragma("unroll") for (int n = 0; n < 2; ++n) _Pragma("unroll") for (int k = 0; k < 2; ++k) \
        acc[ai][bj][m][n] = __builtin_amdgcn_mfma_f32_16x16x32_f16(Bt[n][k], At[m][k], acc[ai][bj][m][n], 0, 0, 0); __builtin_amdgcn_s_setprio(0); } while (0)
#define G8_WAIT_V(n) asm volatile("s_waitcnt vmcnt(" #n ")" ::: "memory")
#define G8_WAIT_L(n) asm volatile("s_waitcnt lgkmcnt(" #n ")" ::: "memory")
#define G8_BAR __builtin_amdgcn_s_barrier()
#define G8_SCHED __builtin_amdgcn_sched_barrier(0)
    Unit cur, nxt; int ui = 0;
    if (!S.next(0, cur)) return;
    f32x4 acc[2][2][4][2];
#pragma unroll
    for (int a = 0; a < 2; ++a)
#pragma unroll
        for (int b = 0; b < 2; ++b)
#pragma unroll
            for (int m = 0; m < 4; ++m)
#pragma unroll
                for (int n = 0; n < 2; ++n) acc[a][b][m][n] = (f32x4){0.f, 0.f, 0.f, 0.f};
    h16x8 At[4][2], B0[2][2], B1[2][2];
    const char* cA = P.a_base(cur); const char* cB = P.b_base(cur);
    unsigned voffA[2][2], nvoffA[2][2];
    P.fill_voffA(cur, voffA, tid);
#pragma unroll
    for (int h = 0; h < 2; ++h)
#pragma unroll
        for (int i = 0; i < 2; ++i) nvoffA[h][i] = voffA[h][i];
    G8_STAGE(G8_SB(0, 0), cB, voffB); G8_STAGE(G8_SB(0, 1), cB + hstepB, voffB); G8_STAGE(G8_SA(0, 0), cA, voffA[0]); G8_STAGE(G8_SA(0, 1), cA, voffA[1]);
    if (wr == 1) G8_BAR;
    G8_WAIT_V(2); G8_BAR;
    G8_STAGE(G8_SB(1, 0), cB + kstep, voffB); G8_STAGE(G8_SA(1, 0), cA + kstep, voffA[0]); G8_STAGE(G8_SB(1, 1), cB + hstepB + kstep, voffB);
    G8_WAIT_V(6); G8_BAR;
    for (;;) {
        const bool has_next = S.next(ui + 1, nxt);
        const char* nA = has_next ? P.a_base(nxt) : cA; const char* nB = has_next ? P.b_base(nxt) : cB;
        if (Prob::GATHER) { if (has_next) P.fill_voffA(nxt, nvoffA, tid); }
        for (int t = 0; t < nt; t += 2) {
            const bool last = (t == nt - 2);
            if (Prob::HOOK) { if (t == (nt >> 1)) P.hook(acc, cur, wr, wc, fr, fq); }
            const char* a1 = cA + (size_t)(t + 1) * kstep;
            const char* a2 = last ? nA : cA + (size_t)(t + 2) * kstep; const char* b2 = last ? nB : cB + (size_t)(t + 2) * kstep;
            const char* a3 = a2 + kstep; const char* b3 = b2 + kstep;
            G8_LDB(B0, 0, 0); G8_LDB(B1, 0, 1); G8_SCHED; G8_LDA(At, 0, 0); G8_STAGE(G8_SA(1, 1), a1, voffA[1]);
            G8_WAIT_V(8); G8_WAIT_L(0); G8_BAR; G8_MMA(0, 0, At, B0); G8_MMA(0, 1, At, B1); G8_BAR; G8_SCHED;
            if (Prob::GATHER) { if (last) {
#pragma unroll
                for (int h = 0; h < 2; ++h)
#pragma unroll
                    for (int i = 0; i < 2; ++i) voffA[h][i] = nvoffA[h][i]; } }
            G8_LDA(At, 0, 1); G8_STAGE(G8_SB(0, 0), b2, voffB); G8_STAGE(G8_SB(0, 1), b2 + hstepB, voffB); G8_STAGE(G8_SA(0, 0), a2, voffA[0]);
            G8_WAIT_V(8); G8_WAIT_L(0); G8_BAR; G8_MMA(1, 0, At, B0); G8_MMA(1, 1, At, B1); G8_BAR; G8_SCHED;
            G8_LDB(B0, 1, 0); G8_LDB(B1, 1, 1); G8_SCHED; G8_LDA(At, 1, 0); G8_STAGE(G8_SA(0, 1), a2, voffA[1]);
            G8_WAIT_V(8); G8_WAIT_L(0); G8_BAR; G8_MMA(0, 0, At, B0); G8_MMA(0, 1, At, B1); G8_BAR; G8_SCHED;
            G8_LDA(At, 1, 1); G8_STAGE(G8_SB(1, 0), b3, voffB); G8_STAGE(G8_SB(1, 1), b3 + hstepB, voffB); G8_STAGE(G8_SA(1, 0), a3, voffA[0]);
            G8_WAIT_V(8); G8_WAIT_L(0); G8_BAR; G8_MMA(1, 0, At, B0); G8_MMA(1, 1, At, B1); G8_BAR; G8_SCHED;
        }
        if constexpr (ALIGN_EPI) { if (wr == 0) G8_BAR; }
        E(acc, cur, wr, wc, fr, fq);
        if (!has_next) break;
#pragma unroll
        for (int a = 0; a < 2; ++a)
#pragma unroll
            for (int b = 0; b < 2; ++b)
#pragma unroll
                for (int m = 0; m < 4; ++m)
#pragma unroll
                    for (int n = 0; n < 2; ++n) acc[a][b][m][n] = (f32x4){0.f, 0.f, 0.f, 0.f};
        cur = nxt; cA = nA; cB = nB; ++ui;
        if constexpr (ALIGN_EPI) { if (wr == 1) G8_BAR; }
    }
    G8_WAIT_V(0);
    if constexpr (!ALIGN_EPI) { if (wr == 0) G8_BAR; }
    G8_BAR;
#undef G8_SA
#undef G8_SB
#undef G8_STAGE
#undef G8_LDA
#undef G8_LDB
#undef G8_MMA
#undef G8_WAIT_V
#undef G8_WAIT_L
#undef G8_BAR
#undef G8_SCHED
}

struct ProbDense {
    static constexpr bool GATHER = false, HOOK = false;
    const char* A; const char* Bt; int K;
    __device__ __forceinline__ const char* a_base(const Unit& u) const { return A + (size_t)u.a * BM * K * 2; }
    __device__ __forceinline__ const char* b_base(const Unit& u) const { return Bt + (size_t)u.b * BM * K * 2; }
    __device__ __forceinline__ void fill_voffA(const Unit&, unsigned (&v)[2][2], int tid) const {
#pragma unroll
        for (int i = 0; i < 2; ++i) { int R, C; stage_rc(tid * 16 + i * 8192, R, C); v[0][i] = (unsigned)(R * K + C) * 2u; v[1][i] = (unsigned)((HALF + R) * K + C) * 2u; }
    }
    __device__ __forceinline__ void hook(f32x4 (&)[2][2][4][2], const Unit&, int, int, int, int) const {}
};
struct ProbWout {
    static constexpr bool GATHER = false, HOOK = true;
    const char* A; const char* Bt; int K; const float* headss;
    __device__ __forceinline__ const char* a_base(const Unit& u) const { return A + (size_t)u.a * BM * K * 2; }
    __device__ __forceinline__ const char* b_base(const Unit& u) const { return Bt + (size_t)u.b * BM * K * 2; }
    __device__ __forceinline__ void fill_voffA(const Unit&, unsigned (&v)[2][2], int tid) const {
#pragma unroll
        for (int i = 0; i < 2; ++i) { int R, C; stage_rc(tid * 16 + i * 8192, R, C); v[0][i] = (unsigned)(R * K + C) * 2u; v[1][i] = (unsigned)((HALF + R) * K + C) * 2u; }
    }
    __device__ __forceinline__ void hook(f32x4 (&acc)[2][2][4][2], const Unit& u, int wr, int wc, int fr, int fq) const {
#pragma unroll
        for (int ai = 0; ai < 2; ++ai)
#pragma unroll
            for (int m = 0; m < 4; ++m) {
                const int row = u.a * BM + ai * HALF + wr * 64 + m * 16 + fr;
                const f32x4* hp = (const f32x4*)(headss + (size_t)row * 16);
                const f32x4 a0 = hp[0], a1 = hp[1], b0 = hp[2], b1 = hp[3];
                const float sa = ((a0[0] + a0[1]) + (a0[2] + a0[3])) + ((a1[0] + a1[1]) + (a1[2] + a1[3]));
                const float sb = ((b0[0] + b0[1]) + (b0[2] + b0[3])) + ((b1[0] + b1[1]) + (b1[2] + b1[3]));
                const float ratio = rsqrtf(sa * (1.f / 512.f) + EPS) / rsqrtf(sb * (1.f / 512.f) + EPS);
#pragma unroll
                for (int bj = 0; bj < 2; ++bj)
#pragma unroll
                    for (int n = 0; n < 2; ++n) acc[ai][bj][m][n] *= ratio;
            }
    }
};
struct ProbMoe1 {
    static constexpr bool GATHER = true, HOOK = false;
    const char* A; const char* Bt; int K; const unsigned* list; const LAS int* cn;
    __device__ __forceinline__ const char* a_base(const Unit&) const { return A; }
    __device__ __forceinline__ const char* b_base(const Unit& u) const { return Bt + (size_t)(u.c * 4 + u.b) * BM * K * 2; }
    __device__ __forceinline__ void fill_voffA(const Unit& u, unsigned (&v)[2][2], int tid) const {
        const int n = cn[u.c];
#pragma unroll
        for (int i = 0; i < 2; ++i) { int R, C; stage_rc(tid * 16 + i * 8192, R, C);
#pragma unroll
            for (int h = 0; h < 2; ++h) { int idx = u.a * BM + h * HALF + R; idx = idx < n ? idx : n - 1;
                const unsigned ent = list[(size_t)u.c * T + idx];
                v[h][i] = (ent >> 1) * (unsigned)(K * 2) + (unsigned)C * 2u; } }
    }
    __device__ __forceinline__ void hook(f32x4 (&)[2][2][4][2], const Unit&, int, int, int, int) const {}
};
struct ProbMoe2 {
    static constexpr bool GATHER = false, HOOK = false;
    const char* A; const char* Bt; int K;
    __device__ __forceinline__ const char* a_base(const Unit& u) const { return A + (size_t)u.d * BM * K * 2; }
    __device__ __forceinline__ const char* b_base(const Unit& u) const { return Bt + ((size_t)u.c * 1024 + (size_t)u.b * BM) * K * 2; }
    __device__ __forceinline__ void fill_voffA(const Unit&, unsigned (&v)[2][2], int tid) const {
#pragma unroll
        for (int i = 0; i < 2; ++i) { int R, C; stage_rc(tid * 16 + i * 8192, R, C); v[0][i] = (unsigned)(R * K + C) * 2u; v[1][i] = (unsigned)((HALF + R) * K + C) * 2u; }
    }
    __device__ __forceinline__ void hook(f32x4 (&)[2][2][4][2], const Unit&, int, int, int, int) const {}
};

__device__ __forceinline__ u32x4 pack8(const f32x4 v0, const f32x4 v1) { u32x4 w; w.x = pk2(v0[0], v0[1]); w.y = pk2(v0[2], v0[3]); w.z = pk2(v1[0], v1[1]); w.w = pk2(v1[2], v1[3]); return w; }

struct EpiQkv {
    h16* out; const float* rowss0;
    __device__ __forceinline__ void operator()(const f32x4 (&acc)[2][2][4][2], const Unit& u, int wr, int wc, int fr, int fq) const {
        const float cs = (u.b < 2 || u.b == 6 || u.b == 7) ? QSCALE : 1.f;
#pragma unroll
        for (int ai = 0; ai < 2; ++ai)
#pragma unroll
            for (int m = 0; m < 4; ++m) { const int row = u.a * BM + ai * HALF + wr * 64 + m * 16 + fr;
                const float sc = rsqrtf(rowss0[row] * (1.f / 1024.f) + EPS) * cs;
                h16* rowp = out + (size_t)row * INW + u.b * BM + wc * 32 + 8 * fq;
#pragma unroll
                for (int bj = 0; bj < 2; ++bj) *(u32x4*)(rowp + bj * HALF) = pack8(acc[ai][bj][m][0] * sc, acc[ai][bj][m][1] * sc); }
    }
};
struct EpiPlain {
    h16* out; int ldc;
    __device__ __forceinline__ void operator()(const f32x4 (&acc)[2][2][4][2], const Unit& u, int wr, int wc, int fr, int fq) const {
#pragma unroll
        for (int ai = 0; ai < 2; ++ai)
#pragma unroll
            for (int m = 0; m < 4; ++m) { const int row = u.a * BM + ai * HALF + wr * 64 + m * 16 + fr;
                h16* rowp = out + (size_t)row * ldc + u.b * BM + wc * 32 + 8 * fq;
#pragma unroll
                for (int bj = 0; bj < 2; ++bj) *(u32x4*)(rowp + bj * HALF) = pack8(acc[ai][bj][m][0], acc[ai][bj][m][1]); }
    }
};
struct EpiWout {
    const float* x; float* x1; h16* xmh; float* xss; const float* headss;
    __device__ __forceinline__ void operator()(const f32x4 (&acc)[2][2][4][2], const Unit& u, int wr, int wc, int fr, int fq) const {
#pragma unroll
        for (int ai = 0; ai < 2; ++ai)
#pragma unroll
            for (int m = 0; m < 4; ++m) { const int row = u.a * BM + ai * HALF + wr * 64 + m * 16 + fr;
                const f32x4* hp = (const f32x4*)(headss + (size_t)row * 16);
                const f32x4 b0 = hp[2], b1 = hp[3];
                const float sb = ((b0[0] + b0[1]) + (b0[2] + b0[3])) + ((b1[0] + b1[1]) + (b1[2] + b1[3]));
                const float rb = rsqrtf(sb * (1.f / 512.f) + EPS);
                const size_t off = (size_t)row * DM + u.b * BM + wc * 32 + 8 * fq; float ss = 0.f;
#pragma unroll
                for (int bj = 0; bj < 2; ++bj) { const f32x4 xa = *(const f32x4*)(x + off + bj * HALF), xb = *(const f32x4*)(x + off + bj * HALF + 4);
                    const f32x4 v0 = xa + acc[ai][bj][m][0] * rb, v1 = xb + acc[ai][bj][m][1] * rb;
                    *(f32x4*)(x1 + off + bj * HALF) = v0; *(f32x4*)(x1 + off + bj * HALF + 4) = v1;
                    *(u32x4*)(xmh + off + bj * HALF) = pack8(v0, v1);
                    ss += ((v0[0] * v0[0] + v0[1] * v0[1]) + (v0[2] * v0[2] + v0[3] * v0[3])) + ((v1[0] * v1[0] + v1[1] * v1[1]) + (v1[2] * v1[2] + v1[3] * v1[3])); }
                ss += __shfl_xor(ss, 16); ss += __shfl_xor(ss, 32);
                if (fq == 0) xss[(size_t)row * 16 + u.b * 4 + wc] = ss; }
    }
};
struct EpiMoe1 {
    h16* hid; const f32x2* rsw; const LAS int* cn;
    __device__ __forceinline__ void operator()(const f32x4 (&acc)[2][2][4][2], const Unit& u, int wr, int wc, int fr, int fq) const {
        const int nvalid = cn[u.c] - u.a * BM;
#pragma unroll
        for (int ai = 0; ai < 2; ++ai)
#pragma unroll
            for (int m = 0; m < 4; ++m) { const int lrow = ai * HALF + wr * 64 + m * 16 + fr;
                if (lrow < nvalid) {
                    const f32x2 rw = rsw[(size_t)u.c * T + u.a * BM + lrow];
                    f32x4 hv[2];
#pragma unroll
                    for (int n = 0; n < 2; ++n)
#pragma unroll
                        for (int j = 0; j < 4; ++j) { const float g = acc[ai][0][m][n][j] * rw.x, up = acc[ai][1][m][n][j] * rw.x;
                            hv[n][j] = g * __builtin_amdgcn_rcpf(1.f + __builtin_amdgcn_exp2f(-g * LOG2E)) * up * rw.y; }
                    *(u32x4*)(hid + (size_t)(u.d * BM + lrow) * DE + u.b * HALF + wc * 32 + 8 * fq) = pack8(hv[0], hv[1]); } }
    }
};
struct EpiMoe2 {
    h16* y; const unsigned* list; const LAS int* cn;
    __device__ __forceinline__ void operator()(const f32x4 (&acc)[2][2][4][2], const Unit& u, int wr, int wc, int fr, int fq) const {
        const int nvalid = cn[u.c] - u.a * BM;
#pragma unroll
        for (int ai = 0; ai < 2; ++ai)
#pragma unroll
            for (int m = 0; m < 4; ++m) { const int lrow = ai * HALF + wr * 64 + m * 16 + fr;
                if (lrow < nvalid) {
                    const unsigned ent = list[(size_t)u.c * T + u.a * BM + lrow];
                    h16* rowp = y + ((size_t)(ent & 1u) * T + (ent >> 1)) * DM + u.b * BM + wc * 32 + 8 * fq;
#pragma unroll
                    for (int bj = 0; bj < 2; ++bj) *(u32x4*)(rowp + bj * HALF) = pack8(acc[ai][bj][m][0], acc[ai][bj][m][1]); } }
    }
};
struct EpiPle {
    float* xo; const h16* pproj; const float* rowss3; float* xss3;
    __device__ __forceinline__ void operator()(const f32x4 (&acc)[2][2][4][2], const Unit& u, int wr, int wc, int fr, int fq) const {
#pragma unroll
        for (int ai = 0; ai < 2; ++ai)
#pragma unroll
            for (int m = 0; m < 4; ++m) { const int row = u.a * BM + ai * HALF + wr * 64 + m * 16 + fr;
                const float r3 = rsqrtf(rowss3[row] * (1.f / 1024.f) + EPS);
                const size_t off = (size_t)row * DM + u.b * BM + wc * 32 + 8 * fq; float ss = 0.f;
#pragma unroll
                for (int bj = 0; bj < 2; ++bj) { const f32x4 xa = *(const f32x4*)(xo + off + bj * HALF), xb = *(const f32x4*)(xo + off + bj * HALF + 4);
                    const h16x8 pp = *(const h16x8*)(pproj + off + bj * HALF);
                    f32x4 v0, v1;
#pragma unroll
                    for (int j = 0; j < 4; ++j) { const float g0 = __builtin_amdgcn_rcpf(1.f + __builtin_amdgcn_exp2f(-acc[ai][bj][m][0][j] * r3 * LOG2E));
                        const float g1 = __builtin_amdgcn_rcpf(1.f + __builtin_amdgcn_exp2f(-acc[ai][bj][m][1][j] * r3 * LOG2E));
                        v0[j] = xa[j] + (float)pp[j] * g0; v1[j] = xb[j] + (float)pp[4 + j] * g1; }
                    *(f32x4*)(xo + off + bj * HALF) = v0; *(f32x4*)(xo + off + bj * HALF + 4) = v1;
                    ss += ((v0[0] * v0[0] + v0[1] * v0[1]) + (v0[2] * v0[2] + v0[3] * v0[3])) + ((v1[0] * v1[0] + v1[1] * v1[1]) + (v1[2] * v1[2] + v1[3] * v1[3])); }
                ss += __shfl_xor(ss, 16); ss += __shfl_xor(ss, 32);
                if (fq == 0) xss3[(size_t)row * 16 + u.b * 4 + wc] = ss; }
    }
};
}

namespace att {
__device__ __forceinline__ int crow(int r, int hi) { return (r & 3) + 8 * (r >> 2) + 4 * hi; }

struct TaskOut { f32x16 o[2]; float m, l; };

template <int W  >
__device__ __forceinline__ void run_task(const h16* proj, int tokbase, int dstr, int L, int i0, int qcol, int kcol, int vcol, float cslope,
                                         float m_init, float l_init, LAS unsigned char* vl, int lane, TaskOut& R) {
    const int r32 = lane & 31, hi = lane >> 5;
    const h16* qrow = proj + (size_t)(tokbase + dstr * (i0 + r32)) * INW + qcol + 8 * hi;
    h16x8 qf[4];
#pragma unroll
    for (int s = 0; s < 4; ++s) qf[s] = *(const h16x8*)(qrow + 16 * s);
    float m = m_init, l = l_init;
    f32x16 o0 = {}, o1 = {};
    int kt_lo = -(i0 >> 5); kt_lo = kt_lo < -W ? -W : kt_lo;
    int kt_hi = (L - 32 - i0) >> 5; kt_hi = kt_hi > W ? W : kt_hi;
    kt_lo = __builtin_amdgcn_readfirstlane(kt_lo); kt_hi = __builtin_amdgcn_readfirstlane(kt_hi);
    const int wkey = lane >> 3, wch = lane & 7;
    LAS unsigned char* vw = vl + (wch >> 2) * 2048 + wkey * 64 + (wch & 3) * 16;
    const int g = lane >> 4, q4 = (lane & 15) >> 2, p4 = lane & 3;
    LAS unsigned char* vr = vl + (4 * (g >> 1) + q4) * 64 + (16 * (g & 1) + 4 * p4) * 2;
    h16x8 kfn[4], vrn[4];
    {
        const int k0 = i0 + 32 * kt_lo;
        const h16* krow = proj + (size_t)(tokbase + dstr * (k0 + r32)) * INW + kcol + 8 * hi;
#pragma unroll
        for (int s = 0; s < 4; ++s) kfn[s] = *(const h16x8*)(krow + 16 * s);
#pragma unroll
        for (int i = 0; i < 4; ++i) vrn[i] = *(const h16x8*)(proj + (size_t)(tokbase + dstr * (k0 + 8 * i + wkey)) * INW + vcol + 8 * wch);
    }
    for (int kt = kt_lo; kt <= kt_hi; ++kt) {
        h16x8 kf[4], vv[4];
#pragma unroll
        for (int s = 0; s < 4; ++s) { kf[s] = kfn[s]; vv[s] = vrn[s]; }
        if (kt < kt_hi) {
            const int k0 = i0 + 32 * (kt + 1);
            const h16* krow = proj + (size_t)(tokbase + dstr * (k0 + r32)) * INW + kcol + 8 * hi;
#pragma unroll
            for (int s = 0; s < 4; ++s) kfn[s] = *(const h16x8*)(krow + 16 * s);
#pragma unroll
            for (int i = 0; i < 4; ++i) vrn[i] = *(const h16x8*)(proj + (size_t)(tokbase + dstr * (k0 + 8 * i + wkey)) * INW + vcol + 8 * wch);
        }
        asm volatile("" ::: "memory");
#pragma unroll
        for (int i = 0; i < 4; ++i) *(LAS h16x8*)(vw + i * 512) = vv[i];
        asm volatile("" ::: "memory");
        f32x16 st = {};
#pragma unroll
        for (int s = 0; s < 4; ++s) st = __builtin_amdgcn_mfma_f32_32x32x16_f16(kf[s], qf[s], st, 0, 0, 0);
        const float relb = (float)(32 * kt + 4 * hi - r32);
        float mx = -1e30f;
        const bool edge = (kt == -W) || (kt == W);
#pragma unroll
        for (int r = 0; r < 16; ++r) { const float rel = fabsf(relb + (float)((r & 3) + 8 * (r >> 2)));
            float sv = st[r] - cslope * rel;
            if (edge) sv = (rel > (float)(32 * W)) ? -1e30f : sv;
            st[r] = sv; mx = fmaxf(mx, sv); }
        mx = xhalf_max(mx);
        const float mn = fmaxf(m, mx);
        const float alpha = __builtin_amdgcn_exp2f(m - mn);
        m = mn;
        float rs = 0.f;
#pragma unroll
        for (int r = 0; r < 16; ++r) { const float pv = __builtin_amdgcn_exp2f(st[r] - mn); st[r] = pv; rs += pv; }
        l = l * alpha + rs;
#pragma unroll
        for (int r = 0; r < 16; ++r) { o0[r] *= alpha; o1[r] *= alpha; }
        u32x4 pw0, pw1;
        pw0.x = pk2(st[0], st[1]); pw0.y = pk2(st[2], st[3]); pw0.z = pk2(st[4], st[5]); pw0.w = pk2(st[6], st[7]);
        pw1.x = pk2(st[8], st[9]); pw1.y = pk2(st[10], st[11]); pw1.z = pk2(st[12], st[13]); pw1.w = pk2(st[14], st[15]);
        const h16x8 pf0 = __builtin_bit_cast(h16x8, pw0), pf1 = __builtin_bit_cast(h16x8, pw1);
        asm volatile("" ::: "memory");
#define ATT_VTR(n, s, b) __builtin_amdgcn_ds_read_tr16_b64_v4i16((LAS v4i16_t*)(vr + (n) * 2048 + (s) * 1024 + (b) * 512))
        const v4i16_t a00 = ATT_VTR(0, 0, 0), a01 = ATT_VTR(0, 0, 1), a10 = ATT_VTR(0, 1, 0), a11 = ATT_VTR(0, 1, 1);
        const v4i16_t b00 = ATT_VTR(1, 0, 0), b01 = ATT_VTR(1, 0, 1), b10 = ATT_VTR(1, 1, 0), b11 = ATT_VTR(1, 1, 1);
#undef ATT_VTR
        asm volatile("" ::: "memory");
#define ATT_CAT(x, y) __builtin_bit_cast(h16x8, (s16x8){x[0], x[1], x[2], x[3], y[0], y[1], y[2], y[3]})
        o0 = __builtin_amdgcn_mfma_f32_32x32x16_f16(ATT_CAT(a00, a01), pf0, o0, 0, 0, 0);
        o0 = __builtin_amdgcn_mfma_f32_32x32x16_f16(ATT_CAT(a10, a11), pf1, o0, 0, 0, 0);
        o1 = __builtin_amdgcn_mfma_f32_32x32x16_f16(ATT_CAT(b00, b01), pf0, o1, 0, 0, 0);
        o1 = __builtin_amdgcn_mfma_f32_32x32x16_f16(ATT_CAT(b10, b11), pf1, o1, 0, 0, 0);
#undef ATT_CAT
    }
    R.o[0] = o0; R.o[1] = o1; R.m = m; R.l = xhalf_sum(l);
}

__device__ __forceinline__ float store_o(const TaskOut& R, float inv, h16* dst, int hi) {
    float ss = 0.f;
#pragma unroll
    for (int n = 0; n < 2; ++n)
#pragma unroll
        for (int g = 0; g < 4; ++g) { const float a = R.o[n][4 * g] * inv, b = R.o[n][4 * g + 1] * inv, c = R.o[n][4 * g + 2] * inv, d = R.o[n][4 * g + 3] * inv;
            ss += (a * a + b * b) + (c * c + d * d);
            u32x2 w; w.x = pk2(a, b); w.y = pk2(c, d); *(u32x2*)(dst + 32 * n + 8 * g + 4 * hi) = w; }
    return ss;
}

__device__ __forceinline__ void unit_a(const h16* proj, h16* oc, float* lsec, h16* o, float* headss, int b, int h, int blk, LAS unsigned char* vl, int wid, int lane) {
    const int r32 = lane & 31, hi = lane >> 5;
    const float slope = __builtin_amdgcn_exp2f(-(float)(h + 1));
#pragma unroll 1
    for (int k = wid; k < 48; k += 8) {
        const int c = k >> 4, j = k & 15;
        const int dsh = 2 * c, d = 1 << dsh;
        const int tpr = 16 >> dsh;
        const int res = j / tpr, ti = j % tpr;
        const int L = SEQ >> dsh, i0 = blk * (512 >> dsh) + 32 * ti;
        TaskOut R;
        run_task<2>(proj, b * SEQ + res, d, L, i0, h * 64, 512 + h * 64, 1024 + h * 64, slope * (float)d * LOG2E, -1e30f, 0.f, vl, lane, R);
        const int tok = b * SEQ + res + d * (i0 + r32);
        const float inv = 1.f / R.l;
        (void)store_o(R, inv, oc + ((size_t)c * T + tok) * 512 + h * 64, hi);
        if (hi == 0) lsec[((size_t)c * T + tok) * 8 + h] = R.m + __builtin_amdgcn_logf(R.l);
    }
    __syncthreads();
#pragma unroll 1
    for (int i = 0; i < 64; ++i) {
        const int tok = b * SEQ + blk * 512 + wid * 64 + i;
        const float l0 = lsec[((size_t)0 * T + tok) * 8 + h], l1 = lsec[((size_t)1 * T + tok) * 8 + h], l2 = lsec[((size_t)2 * T + tok) * 8 + h];
        const float mx = fmaxf(l0, fmaxf(l1, l2));
        const float w0 = __builtin_amdgcn_exp2f(l0 - mx), w1 = __builtin_amdgcn_exp2f(l1 - mx), w2 = __builtin_amdgcn_exp2f(l2 - mx);
        const float inv = 1.f / (w0 + w1 + w2);
        const float v0 = (float)oc[((size_t)0 * T + tok) * 512 + h * 64 + lane], v1 = (float)oc[((size_t)1 * T + tok) * 512 + h * 64 + lane], v2 = (float)oc[((size_t)2 * T + tok) * 512 + h * 64 + lane];
        const float ov = (w0 * v0 + w1 * v1 + w2 * v2) * inv;
        o[(size_t)tok * DM + h * 64 + lane] = (h16)ov;
        const float ss = wave_sum(ov * ov);
        if (lane == 0) headss[(size_t)tok * 16 + h] = ss;
    }
}
__device__ __forceinline__ void unit_b(const h16* proj, const float* sink, h16* o, float* headss, int b, int hq, int blk, LAS unsigned char* vl, int wid, int lane) {
    const int r32 = lane & 31, hi = lane >> 5, hk = hq >> 2;
    const float slope = __builtin_amdgcn_exp2f(-(float)(hq + 1));
    const float sk = sink[hq] * LOG2E;
#pragma unroll 1
    for (int j = wid; j < 16; j += 8) {
        const int i0 = blk * 512 + 32 * j;
        TaskOut R;
        run_task<4>(proj, b * SEQ, 1, SEQ, i0, 1536 + hq * 64, 2048 + hk * 64, 2176 + hk * 64, slope * LOG2E, sk, hi == 0 ? 1.f : 0.f, vl, lane, R);
        const int tok = b * SEQ + i0 + r32;
        float ss = store_o(R, 1.f / R.l, o + (size_t)tok * DM + 512 + hq * 64, hi);
        ss = xhalf_sum(ss);
        if (hi == 0) headss[(size_t)tok * 16 + 8 + hq] = ss;
    }
}
}

#define XB_TMO      128
#define XB_XCNT(j)  (256  + 64 * (j))
#define XB_XSUB(j)  (1280 + 64 * (j))
#define XB_XGEN(j)  (2304 + 64 * (j))
#define XB_TOP      3328
#define XB_TOPGEN   3392
#define XCD_BAR_WORDS 3456
#define XB_SPIN_CAP (1u << 20)
__device__ __forceinline__ unsigned xb_ld(unsigned* p)              { return __hip_atomic_load(p, __ATOMIC_RELAXED, __HIP_MEMORY_SCOPE_AGENT); }
__device__ __forceinline__ unsigned xb_add(unsigned* p, unsigned v) { return __hip_atomic_fetch_add(p, v, __ATOMIC_RELAXED, __HIP_MEMORY_SCOPE_AGENT); }
__device__ __forceinline__ unsigned xb_xcc_id() { return (unsigned)__builtin_amdgcn_s_getreg((3 << 11) | 20) & 0xFu; }
#define XB_SPIN(cond, bar) do { unsigned _sp = 0; while (cond) { __builtin_amdgcn_s_sleep(1); \
    if ((++_sp & 255u) == 0u) { if (xb_ld(&(bar)[XB_TMO])) break; if (_sp > XB_SPIN_CAP) { atomicAdd(&(bar)[XB_TMO], 1u); break; } } } } while (0)
struct XcdBarrier { unsigned* bar; unsigned x; volatile LAS unsigned* st; };
__device__ __forceinline__ XcdBarrier xcd_barrier_post(unsigned* bar, volatile LAS unsigned* st) {
    XcdBarrier b; b.bar = bar; b.x = xb_xcc_id(); b.st = st;
    if (threadIdx.x == 0) (void)xb_add(&bar[XB_XCNT(b.x)], 1u);
    return b;
}
__device__ __forceinline__ void xcd_barrier_complete(unsigned* bar, unsigned x, unsigned& nloc, unsigned& nx) {
    const unsigned G = gridDim.x * gridDim.y * gridDim.z;
    unsigned sum, cnt, mine, sp = 0u;
    for (;;) {
        sum = 0u; cnt = 0u; mine = 0u;
#pragma unroll
        for (unsigned j = 0; j < 16; ++j) { const unsigned c = xb_ld(&bar[XB_XCNT(j)]); sum += c; cnt += (c > 0u) ? 1u : 0u; mine = (j == x) ? c : mine; }
        if (sum == G) break;
        __builtin_amdgcn_s_sleep(1);
        if ((++sp & 255u) == 0u) { if (xb_ld(&bar[XB_TMO])) break; if (sp > XB_SPIN_CAP) { atomicAdd(&bar[XB_TMO], 1u); break; } }
    }
    nloc = mine > 0u ? mine : 1u; nx = cnt > 0u ? cnt : 1u;
}
__device__ __forceinline__ void xcd_barrier(const XcdBarrier& b) {
    asm volatile("s_waitcnt vmcnt(0)" ::: "memory");
    __syncthreads();
    if (threadIdx.x == 0) {
        unsigned* bar = b.bar;
        __builtin_amdgcn_s_waitcnt(0);
        unsigned nloc = b.st[0], nx = b.st[1];
        if (nloc == 0u) { xcd_barrier_complete(bar, b.x, nloc, nx); b.st[0] = nloc; b.st[1] = nx; }
        const unsigned old = xb_add(&bar[XB_XSUB(b.x)], 1u);
        const unsigned gen = old / nloc;
        if (old + 1u == (gen + 1u) * nloc) {
            __builtin_amdgcn_fence(__ATOMIC_RELEASE, "agent");
            asm volatile("s_waitcnt vmcnt(0)" ::: "memory");
            const unsigned og = xb_add(&bar[XB_TOP], 1u);
            const unsigned tg = og / nx;
            if (og + 1u == (tg + 1u) * nx) xb_add(&bar[XB_TOPGEN], 1u);
            else XB_SPIN(xb_ld(&bar[XB_TOPGEN]) == tg, bar);
            __builtin_amdgcn_fence(__ATOMIC_ACQUIRE, "agent");
            xb_add(&bar[XB_XGEN(b.x)], 1u);
            asm volatile("s_waitcnt vmcnt(0)" ::: "memory");
        } else {
            XB_SPIN(xb_ld(&bar[XB_XGEN(b.x)]) == gen, bar);
            __builtin_amdgcn_fence(__ATOMIC_ACQUIRE, "agent");
            asm volatile("s_waitcnt vmcnt(0)" ::: "memory");
        }
    }
    __syncthreads();
}

constexpr int NWAVES = 8;
constexpr int NPH = 10;
struct Args { const float* in[20]; float* out; unsigned char* ws; int ph_lo, ph_hi, li, pad; };

__device__ __forceinline__ void p0_transpose_item(const float* W, int ldw, int k0, int n0, h16* dst, int Kd, int drow0, const float* gain, LAS float* scr, int lane) {
#pragma unroll 8
    for (int i = 0; i < 32; ++i) { const int kk = 2 * i + (lane >> 5); float v = W[(size_t)(k0 + kk) * ldw + n0 + (lane & 31)]; if (gain) v *= gain[k0 + kk]; scr[kk * 33 + (lane & 31)] = v; }
    LDS_WAIT(); asm volatile("" ::: "memory");
    const int c = lane & 7;
#pragma unroll
    for (int j = 0; j < 4; ++j) { const int n = (lane >> 3) + 8 * j; const LAS float* s = scr + (8 * c) * 33 + n;
        u32x4 o; o.x = pk2(s[0 * 33], s[1 * 33]); o.y = pk2(s[2 * 33], s[3 * 33]); o.z = pk2(s[4 * 33], s[5 * 33]); o.w = pk2(s[6 * 33], s[7 * 33]);
        *(u32x4*)(dst + (size_t)(drow0 + n) * Kd + k0 + 8 * c) = o; }
    LDS_WAIT(); asm volatile("" ::: "memory");
}

__global__ void __launch_bounds__(NWAVES * 64, 2) mk_fwd(Args args) {
    extern __shared__ __attribute__((aligned(16))) unsigned char lds_raw[];
    LAS unsigned char* lds = (LAS unsigned char*)lds_raw;
    const int tid = threadIdx.x, lane = tid & 63, wid = __builtin_amdgcn_readfirstlane(tid >> 6);
    const int G = gridDim.x, bx = blockIdx.x;
    const int vcu = (G % 8 == 0) ? (bx % 8) * (G / 8) + bx / 8 : bx;
    unsigned char* ws = args.ws;
    unsigned* ctl = (unsigned*)(ws + WS_CTL);
    const float* x = args.in[0]; const float* pin = args.in[1]; const float* g_mix = args.in[2]; const float* w_in = args.in[3];
    const float* sink = args.in[4]; const float* g_ga = args.in[5]; const float* g_gb = args.in[6]; const float* w_out = args.in[7];
    const float* g_ffn = args.in[8]; const float* wrg = args.in[9]; const float* brg = args.in[10]; const float* wre = args.in[11];
    const float* bre = args.in[12]; const float* wg = args.in[13]; const float* wu = args.in[14]; const float* wd = args.in[15];
    const float* g_ple = args.in[16]; const float* wpg = args.in[17]; const float* wpp = args.in[18]; const float* g_fin = args.in[19];
    float* out = args.out;
    h16* Win_t = (h16*)(ws + WS_WIN); h16* Wout_t = (h16*)(ws + WS_WOUT); h16* Wr_t = (h16*)(ws + WS_WR); h16* Wpg_t = (h16*)(ws + WS_WPG); h16* Wpp_t = (h16*)(ws + WS_WPP);
    h16* Wd_t = (h16*)(ws + WS_WD); h16* Wgu_t = (h16*)(ws + WS_WGU); h16* Yb = (h16*)(ws + WS_Y);
    h16* proj = (h16*)(ws + WS_PROJ); h16* xmh = (h16*)(ws + WS_XMH); h16* x2h = (h16*)(ws + WS_X2H); h16* hid = (h16*)(ws + WS_HID);
    h16* xh = (h16*)(ws + WS_XH); h16* ob = (h16*)(ws + WS_O); h16* pproj = (h16*)(ws + WS_PPROJ); h16* ph = (h16*)(ws + WS_PH);
    float* rowss0 = (float*)(ws + WS_ROWSS0); float* headss = (float*)(ws + WS_HEADSS); float* lsec = (float*)(ws + WS_LSEC); float* xss = (float*)(ws + WS_XSS);
    unsigned* list = (unsigned*)(ws + WS_LIST); f32x2* rsw = (f32x2*)(ws + WS_RSW); float* rowss3 = (float*)(ws + WS_ROWSS3); float* xss3 = (float*)(ws + WS_XSS3);
    h16* oc = (h16*)out;
    LAS int* gt = (LAS int*)(lds + MOE_GT_OFF); LAS int* cn = (LAS int*)(lds + MOE_CN_OFF);

    for (int u = tid; u < (LDS_BYTES - LDSCTL_OFF) / 4; u += NWAVES * 64) ((LAS unsigned*)(lds + LDSCTL_OFF))[u] = 0u;
    __syncthreads();
    XcdBarrier bar; bar.bar = ctl + CW_BAR + args.li * XCD_BAR_WORDS; bar.x = 0; bar.st = nullptr;
    const int lo = args.ph_lo, hi = args.ph_hi;
    if (hi - lo > 1) bar = xcd_barrier_post(ctl + CW_BAR + args.li * XCD_BAR_WORDS, (volatile LAS unsigned*)(lds + MISC_OFF));
#define IN(k) (lo <= (k) && (k) < hi)
#define SEAM(k) do { if (IN(k) && IN((k) + 1)) xcd_barrier(bar); } while (0)
    const int gw = vcu * NWAVES + wid, NGW = G * NWAVES;

    if (IN(0)) {
        LAS float* scr = (LAS float*)(lds + wid * 16384);
        constexpr int I_IN = 16 * 72, I_OUT = 16 * 32, I_PG = 16 * 32, I_PP = 4 * 32, I_GU = NE * 2 * 16 * 16, I_D = NE * 8 * 32;
        constexpr int NITEMS = I_IN + I_OUT + I_PG + I_PP + I_GU + I_D;
        for (int it = gw; it < NITEMS; it += NGW) {
            int r = it;
            if (r < I_IN) { const int kb = r / 72, nb = r % 72; p0_transpose_item(w_in, INW, 64 * kb, 32 * nb, Win_t, DM, 32 * nb, g_mix, scr, lane); continue; } r -= I_IN;
            if (r < I_OUT) { const int kb = r / 32, nb = r % 32; p0_transpose_item(w_out, DM, 64 * kb, 32 * nb, Wout_t, DM, 32 * nb, kb < 8 ? g_ga : g_gb - 512, scr, lane); continue; } r -= I_OUT;
            if (r < I_PG) { const int kb = r / 32, nb = r % 32; p0_transpose_item(wpg, DM, 64 * kb, 32 * nb, Wpg_t, DM, 32 * nb, g_ple, scr, lane); continue; } r -= I_PG;
            if (r < I_PP) { const int kb = r / 32, nb = r % 32; p0_transpose_item(wpp, DM, 64 * kb, 32 * nb, Wpp_t, PLE, 32 * nb, nullptr, scr, lane); continue; } r -= I_PP;
            if (r < I_GU) { const int e = r / 512, q = r % 512, isup = q / 256, q2 = q % 256, kb = q2 / 16, nb = q2 % 16;
                const float* src = (isup ? wu : wg) + (size_t)e * DM * DE;
                h16* dst = Wgu_t + (size_t)e * 4 * 256 * DM;
                p0_transpose_item(src, DE, 64 * kb, 32 * nb, dst, DM, (nb >> 2) * 256 + isup * 128 + (nb & 3) * 32, g_ffn, scr, lane); continue; } r -= I_GU;
            { const int e = r / 256, q = r % 256, kb = q / 32, nb = q % 32;
                p0_transpose_item(wd + (size_t)e * DE * DM, DM, 64 * kb, 32 * nb, Wd_t + (size_t)e * DM * DE, DE, 32 * nb, nullptr, scr, lane); }
        }
        for (int i = bx * 512 + tid; i < 48 * DM; i += G * 512) { const int n = i / DM, k = i % DM;
            float v = 0.f; if (n < 4) v = wrg[k * 4 + n]; else if (n < 36) v = wre[k * 32 + (n - 4)];
            Wr_t[i] = (h16)(v * g_ffn[k]); }
        for (int m = gw; m < T; m += NGW) {
            const f32x4* xr = (const f32x4*)(x + (size_t)m * DM) + lane; float s = 0.f;
            unsigned long long* o8 = (unsigned long long*)(xh + (size_t)m * DM) + lane;
#pragma unroll
            for (int j = 0; j < 4; ++j) { const f32x4 v = xr[64 * j]; s += (v[0] * v[0] + v[1] * v[1]) + (v[2] * v[2] + v[3] * v[3]);
                o8[64 * j] = (unsigned long long)pk2(v[0], v[1]) | ((unsigned long long)pk2(v[2], v[3]) << 32); }
            s = wave_sum(s); if (lane == 0) rowss0[m] = s;
        }
        for (int i = bx * 512 + tid; i < T * PLE / 4; i += G * 512) { const f32x4 v = ((const f32x4*)pin)[i];
            ((unsigned long long*)ph)[i] = (unsigned long long)pk2(v[0], v[1]) | ((unsigned long long)pk2(v[2], v[3]) << 32); }
    }
    SEAM(0);
    if (IN(1)) {
        { g8::ProbDense P{(const char*)xh, (const char*)Win_t, DM}; g8::StaticOrder S; S.init(T, INW, G, bx);
          g8::EpiQkv E{proj, rowss0};
          g8::gemm_phase<g8::ProbDense, g8::EpiQkv, g8::StaticOrder, true>(lds, P, S, E); }
        { g8::ProbDense P{(const char*)ph, (const char*)Wpp_t, PLE}; g8::StaticOrder S; S.init(T, DM, G, bx);
          g8::EpiPlain E{pproj, DM};
          g8::gemm_phase<g8::ProbDense, g8::EpiPlain, g8::StaticOrder, true>(lds, P, S, E); }
    }
    SEAM(1);
    if (IN(2)) {
        LAS unsigned char* vl = lds + wid * 4096;
        for (int u = vcu; u < 256; u += G) { const int b = u >> 6, h = (u >> 3) & 7, blk = u & 7;
            att::unit_a(proj, oc, lsec, ob, headss, b, h, blk, vl, wid, lane); }
        for (int u = vcu; u < 256; u += G) { const int b = u >> 6, hq = (u >> 3) & 7, blk = u & 7;
            att::unit_b(proj, sink, ob, headss, b, hq, blk, vl, wid, lane); }
    }
    SEAM(2);
    if (IN(3)) {
        g8::ProbWout P{(const char*)ob, (const char*)Wout_t, DM, headss}; g8::StaticOrder S; S.init(T, DM, G, bx);
        g8::EpiWout E{x, out, xmh, xss, headss};
        g8::gemm_phase<g8::ProbWout, g8::EpiWout, g8::StaticOrder, true>(lds, P, S, E);
    }
    SEAM(3);
    if (IN(4)) {
        LAS float* lg = (LAS float*)(lds + wid * 4096);
        const int fr = lane & 15, fq = lane >> 4;
        for (int tb = gw; tb < T / 16; tb += NGW) {
            const int tok = tb * 16 + fr;
            f32x4 a0 = {0.f, 0.f, 0.f, 0.f}, a1 = a0, a2 = a0;
            const h16* xr = xmh + (size_t)tok * DM + 8 * fq;
            const h16* w0 = Wr_t + (size_t)fr * DM + 8 * fq;
#pragma unroll 4
            for (int k0 = 0; k0 < DM; k0 += 32) {
                const h16x8 bx8 = *(const h16x8*)(xr + k0);
                const h16x8 wa = *(const h16x8*)(w0 + k0), wb = *(const h16x8*)(w0 + 16 * DM + k0), wc8 = *(const h16x8*)(w0 + 32 * DM + k0);
                a0 = __builtin_amdgcn_mfma_f32_16x16x32_f16(wa, bx8, a0, 0, 0, 0);
                a1 = __builtin_amdgcn_mfma_f32_16x16x32_f16(wb, bx8, a1, 0, 0, 0);
                a2 = __builtin_amdgcn_mfma_f32_16x16x32_f16(wc8, bx8, a2, 0, 0, 0);
            }
            asm volatile("" ::: "memory");
#pragma unroll
            for (int j = 0; j < 4; ++j) { lg[fr * 48 + 4 * fq + j] = a0[j]; lg[fr * 48 + 16 + 4 * fq + j] = a1[j]; lg[fr * 48 + 32 + 4 * fq + j] = a2[j]; }
            asm volatile("" ::: "memory");
            LDS_WAIT();
            if (lane < 16) {
                const int t = tb * 16 + lane;
                const f32x4* sp = (const f32x4*)(xss + (size_t)t * 16);
                const f32x4 s0 = sp[0], s1 = sp[1], s2 = sp[2], s3 = sp[3];
                const float ssum = (((s0[0] + s0[1]) + (s0[2] + s0[3])) + ((s1[0] + s1[1]) + (s1[2] + s1[3]))) + (((s2[0] + s2[1]) + (s2[2] + s2[3])) + ((s3[0] + s3[1]) + (s3[2] + s3[3])));
                const float r2 = rsqrtf(ssum * (1.f / 1024.f) + EPS);
                const LAS float* ll = lg + lane * 48;
                float gl[4];
#pragma unroll
                for (int i = 0; i < 4; ++i) gl[i] = ll[i] * r2 + brg[i];
                int gs = 0; float gm = gl[0];
#pragma unroll
                for (int i = 1; i < 4; ++i) if (gl[i] > gm) { gm = gl[i]; gs = i; }
                float den = 0.f;
#pragma unroll
                for (int i = 0; i < 4; ++i) den += __expf(gl[i] - gm);
                const float gwt = 1.f / den;
                float v0 = -3e38f, v1 = -3e38f; int i0 = 0, i1 = 0;
#pragma unroll
                for (int i = 0; i < 8; ++i) { const float v = ll[4 + gs * 8 + i] * r2 + bre[gs * 8 + i];
                    if (v > v0) { v1 = v0; i1 = i0; v0 = v; i0 = i; } else if (v > v1) { v1 = v; i1 = i; } }
                const float e1 = __expf(v1 - v0);
                const float wt0 = gwt / (1.f + e1), wt1 = gwt * e1 / (1.f + e1);
                const int e0 = gs * 8 + i0, e1i = gs * 8 + i1;
                const unsigned p0 = atomicAdd(ctl + CW_CNT + 16 * e0, 1u);
                const unsigned p1 = atomicAdd(ctl + CW_CNT + 16 * e1i, 1u);
                list[(size_t)e0 * T + p0] = (unsigned)t * 2u; rsw[(size_t)e0 * T + p0] = (f32x2){r2, wt0};
                list[(size_t)e1i * T + p1] = (unsigned)t * 2u + 1u; rsw[(size_t)e1i * T + p1] = (f32x2){r2, wt1};
            }
            asm volatile("" ::: "memory");
        }
    }
    SEAM(4);
    if (IN(5) || IN(6)) {
        if (tid < 32) cn[tid] = (int)__hip_atomic_load(ctl + CW_CNT + 16 * tid, RLX_AGENT);
        __syncthreads();
        if (tid == 0) { int s = 0; for (int e = 0; e < 32; ++e) { gt[e] = s; s += (cn[e] + 255) >> 8; } gt[32] = s; }
        __syncthreads();
    }
    if (IN(5)) {
        g8::ProbMoe1 P{(const char*)xmh, (const char*)Wgu_t, DM, list, cn}; g8::MoeOrder S{G, vcu, gt};
        g8::EpiMoe1 E{hid, rsw, cn};
        g8::gemm_phase<g8::ProbMoe1, g8::EpiMoe1, g8::MoeOrder, true>(lds, P, S, E);
    }
    SEAM(5);
    if (IN(6)) {
        g8::ProbMoe2 P{(const char*)hid, (const char*)Wd_t, DE}; g8::MoeOrder S{G, vcu, gt};
        g8::EpiMoe2 E{Yb, list, cn};
        g8::gemm_phase<g8::ProbMoe2, g8::EpiMoe2, g8::MoeOrder, true>(lds, P, S, E);
    }
    SEAM(6);
    if (IN(7)) {
        for (int m = gw; m < T; m += NGW) {
            f32x4* xr = (f32x4*)(out + (size_t)m * DM) + lane; float s = 0.f;
            const unsigned long long* y0 = (const unsigned long long*)(Yb + (size_t)m * DM) + lane; const unsigned long long* y1 = (const unsigned long long*)(Yb + ((size_t)T + m) * DM) + lane;
            unsigned long long* o8 = (unsigned long long*)(x2h + (size_t)m * DM) + lane;
#pragma unroll
            for (int j = 0; j < 4; ++j) { f32x4 v = xr[64 * j]; const h16x4 a = __builtin_bit_cast(h16x4, y0[64 * j]), b = __builtin_bit_cast(h16x4, y1[64 * j]);
#pragma unroll
                for (int q = 0; q < 4; ++q) v[q] = v[q] + ((float)a[q] + (float)b[q]);
                s += (v[0] * v[0] + v[1] * v[1]) + (v[2] * v[2] + v[3] * v[3]);
                xr[64 * j] = v; o8[64 * j] = (unsigned long long)pk2(v[0], v[1]) | ((unsigned long long)pk2(v[2], v[3]) << 32); }
            s = wave_sum(s); if (lane == 0) rowss3[m] = s;
        }
    }
    SEAM(7);
    if (IN(8)) {
        g8::ProbDense P{(const char*)x2h, (const char*)Wpg_t, DM}; g8::StaticOrder S; S.init(T, DM, G, bx);
        g8::EpiPle E{out, pproj, rowss3, xss3};
        g8::gemm_phase<g8::ProbDense, g8::EpiPle, g8::StaticOrder, true>(lds, P, S, E);
    }
    SEAM(8);
    if (IN(9)) {
        for (int m = gw; m < T; m += NGW) {
            const f32x4* sp = (const f32x4*)(xss3 + (size_t)m * 16);
            const f32x4 s0 = sp[0], s1 = sp[1], s2 = sp[2], s3 = sp[3];
            const float ssum = (((s0[0] + s0[1]) + (s0[2] + s0[3])) + ((s1[0] + s1[1]) + (s1[2] + s1[3]))) + (((s2[0] + s2[1]) + (s2[2] + s2[3])) + ((s3[0] + s3[1]) + (s3[2] + s3[3])));
            const float r4 = rsqrtf(ssum * (1.f / 1024.f) + EPS);
            f32x4* xr = (f32x4*)(out + (size_t)m * DM) + lane; const f32x4* gf = (const f32x4*)g_fin + lane;
#pragma unroll
            for (int j = 0; j < 4; ++j) { const f32x4 v = xr[64 * j]; xr[64 * j] = v * r4 * gf[64 * j]; }
        }
    }
#undef IN
#undef SEAM
}

extern "C" void kernel_launch(void* const* d_in, const int* in_sizes, int n_in, void* d_out, int out_size, void* d_ws, size_t ws_size, hipStream_t stream) {
    static int grid = 0;
    if (grid == 0) {
        if (n_in != 20 || in_sizes[0] != T * DM || out_size != T * DM || ws_size < WS_END) { fprintf(stderr, "kernel_launch: unexpected shapes / workspace (n_in %d, ws %zu < %zu); nothing launched\n", n_in, ws_size, (size_t)WS_END); grid = -1; return; }
        int dev = 0, cus = 0, per_cu = 0;
        if (hipGetDevice(&dev) != hipSuccess || hipDeviceGetAttribute(&cus, hipDeviceAttributeMultiprocessorCount, dev) != hipSuccess) { grid = -1; return; }
        if (hipFuncSetAttribute((const void*)mk_fwd, hipFuncAttributeMaxDynamicSharedMemorySize, LDS_BYTES) != hipSuccess) { fprintf(stderr, "kernel_launch: hipFuncSetAttribute failed\n"); grid = -1; return; }
        if (hipOccupancyMaxActiveBlocksPerMultiprocessor(&per_cu, (const void*)mk_fwd, NWAVES * 64, LDS_BYTES) != hipSuccess || per_cu < 1) { fprintf(stderr, "kernel_launch: occupancy query says %d blocks per CU\n", per_cu); }
        (void)hipGetLastError();
        grid = cus;
    }
    if (grid < 0) return;
    (void)hipMemsetAsync((char*)d_ws + WS_CTL, 0, CTL_ZERO_BYTES, stream);
    Args a{};
    for (int i = 0; i < 20; ++i) a.in[i] = (const float*)d_in[i];
    a.out = (float*)d_out; a.ws = (unsigned char*)d_ws;
#if MK_N_LAUNCHES == 1
    a.ph_lo = 0; a.ph_hi = NPH; a.li = 0;
    hipLaunchKernelGGL(mk_fwd, dim3(grid), dim3(NWAVES * 64), LDS_BYTES, stream, a);
#else
    for (int ph = 0; ph < NPH; ++ph) { a.ph_lo = ph; a.ph_hi = ph + 1; a.li = 0;
        hipLaunchKernelGGL(mk_fwd, dim3(grid), dim3(NWAVES * 64), LDS_BYTES, stream, a); }
#endif
}
```

```cpp
#include <hip/hip_runtime.h>
#include <cstdio>
#include <cstdint>

#define LAS __attribute__((address_space(3)))
#define GAS __attribute__((address_space(1)))
typedef _Float16 h16;
typedef _Float16 h16x2 __attribute__((ext_vector_type(2)));
typedef _Float16 h16x4 __attribute__((ext_vector_type(4)));
typedef _Float16 h16x8 __attribute__((ext_vector_type(8)));
typedef float f32x2 __attribute__((ext_vector_type(2)));
typedef float f32x4 __attribute__((ext_vector_type(4)));
typedef float f32x16 __attribute__((ext_vector_type(16)));
typedef unsigned u32x2 __attribute__((ext_vector_type(2)));
typedef unsigned u32x4 __attribute__((ext_vector_type(4)));
typedef short v4i16_t __attribute__((ext_vector_type(4)));
typedef short s16x8 __attribute__((ext_vector_type(8)));
typedef GAS unsigned gu32;

#ifndef MK_N_LAUNCHES
#define MK_N_LAUNCHES 1
#endif
#ifndef MK_DUP
#define MK_DUP -1
#endif
#ifndef MK_STAMP
#define MK_STAMP -1
#endif
#define stamps ((volatile LAS unsigned long long*)((LAS unsigned char*)lds_raw + LDSCTL_OFF + 1024))
#define REPS(k) for (int rep_ = 0; rep_ < ((MK_DUP == (k)) ? 2 : 1); ++rep_)

constexpr int T = 16384, SEQ = 4096, DM = 1024, INW = 2304, NE = 32, DE = 512, PLE = 256;
constexpr float EPS = 1e-6f;
constexpr float LOG2E = 1.4426950408889634f;
constexpr float QSCALE = 0.125f * LOG2E;

constexpr size_t MiB = 1u << 20;
constexpr size_t WS_CTL = 0, CTL_ZERO_BYTES = 32768;
constexpr size_t WS_WIN = 1 * MiB;
constexpr size_t WS_WOUT = 6 * MiB;
constexpr size_t WS_WR = 8 * MiB;
constexpr size_t WS_WPG = 9 * MiB;
constexpr size_t WS_WPP = 11 * MiB;
constexpr size_t WS_WD = 12 * MiB;
constexpr size_t WS_WGU = 44 * MiB;
constexpr size_t WS_Y = 44 * MiB;
constexpr size_t WS_PROJ = 108 * MiB;
constexpr size_t WS_XMH = 108 * MiB;
constexpr size_t WS_X2H = 108 * MiB;
constexpr size_t WS_HID = 140 * MiB;
constexpr size_t WS_XH = 180 * MiB;
constexpr size_t WS_O = 180 * MiB;
constexpr size_t WS_PPROJ = 212 * MiB;
constexpr size_t WS_PH = 244 * MiB;
constexpr size_t WS_ROWSS0 = 252 * MiB;
constexpr size_t WS_HEADSS = 253 * MiB;
constexpr size_t WS_LSEC = 254 * MiB;
constexpr size_t WS_XSS = 256 * MiB;
constexpr size_t WS_LIST = 257 * MiB;
constexpr size_t WS_RSW = 259 * MiB;
constexpr size_t WS_ROWSS3 = 263 * MiB;
constexpr size_t WS_XSS3 = 264 * MiB;
constexpr size_t WS_END = 266 * MiB;

constexpr int CW_CNT = 1024;
constexpr int CW_BAR = 4096;

constexpr int RING_BYTES = 131072;
constexpr int LDSCTL_OFF = RING_BYTES;
constexpr int MISC_OFF = LDSCTL_OFF + 64;
constexpr int MOE_GT_OFF = LDSCTL_OFF + 256;
constexpr int MOE_CN_OFF = MOE_GT_OFF + 256;
constexpr int LDS_BYTES = 147456;

__device__ __forceinline__ unsigned pk2(float lo, float hi) { h16x2 v = {(h16)lo, (h16)hi}; return __builtin_bit_cast(unsigned, v); }
__device__ __forceinline__ float wave_sum(float v) {
#pragma unroll
    for (int o = 1; o < 64; o <<= 1) v += __shfl_xor(v, o);
    return v;
}
__device__ __forceinline__ float xhalf_max(float v) { auto rr = __builtin_amdgcn_permlane32_swap(__float_as_uint(v), __float_as_uint(v), false, false); return fmaxf(__uint_as_float(rr[0]), __uint_as_float(rr[1])); }
__device__ __forceinline__ float xhalf_sum(float v) { auto rr = __builtin_amdgcn_permlane32_swap(__float_as_uint(v), __float_as_uint(v), false, false); return __uint_as_float(rr[0]) + __uint_as_float(rr[1]); }
#define LDS_WAIT() asm volatile("s_waitcnt lgkmcnt(0)" ::: "memory")
#define VM_WAIT() asm volatile("s_waitcnt vmcnt(0)" ::: "memory")
#define RLX_AGENT __ATOMIC_RELAXED, __HIP_MEMORY_SCOPE_AGENT

namespace g8 {
constexpr int BM = 256, BK = 64, HALF = 128, HTB = HALF * BK * 2, STAGE_BYTES = 8 * HTB, NXCD = 8, WGM = 8;
__host__ __device__ __forceinline__ int lds_byte(int r, int c) { const int st = (r >> 4) * 2 + (c >> 5), rr = r & 15, cc = c & 31, ob = rr * 64 + cc * 2; return st * 1024 + (ob ^ (((ob >> 9) & 1) << 5)); }
__host__ __device__ __forceinline__ void stage_rc(int b, int& R, int& C) { const int st = b / 1024, sb = b % 1024, swz = sb ^ (((sb >> 9) & 1) << 5); R = (st >> 1) * 16 + swz / 64; C = (st & 1) * 32 + (swz % 64) / 2; }
__host__ __device__ __forceinline__ int perm32(int rho) { const int n = rho >> 4, i = rho & 15; return 8 * (i >> 2) + 4 * n + (i & 3); }

struct Unit { int a, b, c, d; };

struct StaticOrder {
    int nM, nN, nwg, G, c; int dup = 1;
    __device__ void init(int M, int N, int G_, int c_) { nM = M / BM; nN = N / BM; nwg = nM * nN; G = G_; c = c_; }
    __device__ bool next(int i, Unit& u) const {
        long L = (long)i * G + c; if (L >= (long)nwg * dup) return false; const int second = L >= nwg; L %= nwg;
        int wgid = (int)L; { const int q = nwg / NXCD, r = nwg % NXCD, xcd = wgid % NXCD, off = wgid / NXCD; wgid = (xcd < r ? xcd * (q + 1) : r * (q + 1) + (xcd - r) * q) + off; }
        const int nig = WGM * nN, gid = wgid / nig, fm = gid * WGM, gsz = (nM - fm) < WGM ? (nM - fm) : WGM;
        u.a = fm + ((wgid % nig) % gsz); u.b = (wgid % nig) / gsz; u.c = second; u.d = 0; return true;
    }
};
struct MoeOrder {
    int G, vcu; const LAS int* gt;
    __device__ bool next(int i, Unit& u) const {
        const int L = i * G + vcu; const int total = gt[32] * 4; if (L >= total) return false;
        const int rt = L >> 2; int e = 0;
#pragma unroll 1
        for (int j = 1; j < 32; ++j) e += (gt[j] <= rt) ? 1 : 0;
        u.a = rt - gt[e]; u.b = L & 3; u.c = e; u.d = rt; return true;
    }
};

template <class Prob, class Epi, class Sched, bool ALIGN_EPI>
__device__ __forceinline__ void gemm_phase(LAS unsigned char* lds, const Prob& P, const Sched& S, const Epi& E) {
    const int tid = threadIdx.x, wid = __builtin_amdgcn_readfirstlane(tid >> 6), lane = tid & 63, wr = wid >> 2, wc = wid & 3, fr = lane & 15, fq = lane >> 4;
    const int K = P.K, nt = K / BK;
    unsigned voffB[2];
#pragma unroll
    for (int i = 0; i < 2; ++i) { int R, C; stage_rc(tid * 16 + i * 8192, R, C); const int Rb = (R & ~31) + perm32(R & 31); voffB[i] = (unsigned)(Rb * K + C) * 2u; }
    const size_t kstep = (size_t)(BK * 2);
    const size_t hstepB = (size_t)HALF * K * 2;
    const unsigned ldsw = (unsigned)wid * 1024u;
    const int aoff = lds_byte(wr * 64 + fr, fq * 8), boff = lds_byte(wc * 32 + fr, fq * 8);
#define G8_SA(b, h) (((b) * 2 + (h)) * HTB)
#define G8_SB(b, h) ((4 + (b) * 2 + (h)) * HTB)
#define G8_STAGE(bufoff, gbase, voff) do { _Pragma("unroll") for (int _i = 0; _i < 2; ++_i) \
        __builtin_amdgcn_global_load_lds((const unsigned*)((const char*)(gbase) + (voff)[_i]), (LAS unsigned*)(lds + (bufoff) + ldsw + _i * 8192), 16, 0, 0); } while (0)
#define G8_LDA(dst, b, h) do { _Pragma("unroll") for (int m = 0; m < 4; ++m) _Pragma("unroll") for (int k = 0; k < 2; ++k) dst[m][k] = *(const LAS h16x8*)(lds + G8_SA(b, h) + aoff + m * 2048 + k * 1024); } while (0)
#define G8_LDB(dst, b, h) do { _Pragma("unroll") for (int n = 0; n < 2; ++n) _Pragma("unroll") for (int k = 0; k < 2; ++k) dst[n][k] = *(const LAS h16x8*)(lds + G8_SB(b, h) + boff + n * 2048 + k * 1024); } while (0)
#define G8_MMA(ai, bj, At, Bt) do { __builtin_amdgcn_s_setprio(1); _Pragma("unroll") for (int m = 0; m < 4; ++m) _Pragma("unroll") for (int n = 0; n < 2; ++n) _Pragma("unroll") for (int k = 0; k < 2; ++k) \
        acc[ai][bj][m][n] = __builtin_amdgcn_mfma_f32_16x16x32_f16(Bt[n][k], At[m][k], acc[ai][bj][m][n], 0, 0, 0); __builtin_amdgcn_s_setprio(0); } while (0)
#define G8_WAIT_V(n) asm volatile("s_waitcnt vmcnt(" #n ")" ::: "memory")
#define G8_WAIT_L(n) asm volatile("s_waitcnt lgkmcnt(" #n ")" ::: "memory")
#define G8_BAR __builtin_amdgcn_s_barrier()
#define G8_SCHED __builtin_amdgcn_sched_barrier(0)
    Unit cur, nxt; int ui = 0;
    if (!S.next(0, cur)) return;
    f32x4 acc[2][2][4][2];
#pragma unroll
    for (int a = 0; a < 2; ++a)
#pragma unroll
        for (int b = 0; b < 2; ++b)
#pragma unroll
            for (int m = 0; m < 4; ++m)
#pragma unroll
                for (int n = 0; n < 2; ++n) acc[a][b][m][n] = (f32x4){0.f, 0.f, 0.f, 0.f};
    h16x8 At[4][2], B0[2][2], B1[2][2];
    const char* cA = P.a_base(cur); const char* cB = P.b_base(cur);
    unsigned voffA[2][2], nvoffA[2][2];
    P.fill_voffA(cur, voffA, tid);
#pragma unroll
    for (int h = 0; h < 2; ++h)
#pragma unroll
        for (int i = 0; i < 2; ++i) nvoffA[h][i] = voffA[h][i];
    G8_STAGE(G8_SB(0, 0), cB, voffB); G8_STAGE(G8_SB(0, 1), cB + hstepB, voffB); G8_STAGE(G8_SA(0, 0), cA, voffA[0]); G8_STAGE(G8_SA(0, 1), cA, voffA[1]);
    if (wr == 1) G8_BAR;
    G8_WAIT_V(2); G8_BAR;
    G8_STAGE(G8_SB(1, 0), cB + kstep, voffB); G8_STAGE(G8_SA(1, 0), cA + kstep, voffA[0]); G8_STAGE(G8_SB(1, 1), cB + hstepB + kstep, voffB);
    G8_WAIT_V(6); G8_BAR;
    for (;;) {
        const bool has_next = S.next(ui + 1, nxt);
        const char* nA = has_next ? P.a_base(nxt) : cA; const char* nB = has_next ? P.b_base(nxt) : cB;
        if (Prob::GATHER) { if (has_next) P.fill_voffA(nxt, nvoffA, tid); }
        for (int t = 0; t < nt; t += 2) {
            const bool last = (t == nt - 2);
            if (Prob::HOOK) { if (t == (nt >> 1)) P.hook(acc, cur, wr, wc, fr, fq); }
            const char* a1 = cA + (size_t)(t + 1) * kstep;
            const char* a2 = last ? nA : cA + (size_t)(t + 2) * kstep; const char* b2 = last ? nB : cB + (size_t)(t + 2) * kstep;
            const char* a3 = a2 + kstep; const char* b3 = b2 + kstep;
            G8_LDB(B0, 0, 0); G8_LDB(B1, 0, 1); G8_SCHED; G8_LDA(At, 0, 0); G8_STAGE(G8_SA(1, 1), a1, voffA[1]);
            G8_WAIT_V(8); G8_WAIT_L(0); G8_BAR; G8_MMA(0, 0, At, B0); G8_MMA(0, 1, At, B1); G8_BAR; G8_SCHED;
            if (Prob::GATHER) { if (last) {
#pragma unroll
                for (int h = 0; h < 2; ++h)
#pragma unroll
                    for (int i = 0; i < 2; ++i) voffA[h][i] = nvoffA[h][i]; } }
            G8_LDA(At, 0, 1); G8_STAGE(G8_SB(0, 0), b2, voffB); G8_STAGE(G8_SB(0, 1), b2 + hstepB, voffB); G8_STAGE(G8_SA(0, 0), a2, voffA[0]);
            G8_WAIT_V(8); G8_WAIT_L(0); G8_BAR; G8_MMA(1, 0, At, B0); G8_MMA(1, 1, At, B1); G8_BAR; G8_SCHED;
            G8_LDB(B0, 1, 0); G8_LDB(B1, 1, 1); G8_SCHED; G8_LDA(At, 1, 0); G8_STAGE(G8_SA(0, 1), a2, voffA[1]);
            G8_WAIT_V(8); G8_WAIT_L(0); G8_BAR; G8_MMA(0, 0, At, B0); G8_MMA(0, 1, At, B1); G8_BAR; G8_SCHED;
            G8_LDA(At, 1, 1); G8_STAGE(G8_SB(1, 0), b3, voffB); G8_STAGE(G8_SB(1, 1), b3 + hstepB, voffB); G8_STAGE(G8_SA(1, 0), a3, voffA[0]);
            G8_WAIT_V(8); G8_WAIT_L(0); G8_BAR; G8_MMA(1, 0, At, B0); G8_MMA(1, 1, At, B1); G8_BAR; G8_SCHED;
        }
        if constexpr (ALIGN_EPI) { if (wr == 0) G8_BAR; }
        E(acc, cur, wr, wc, fr, fq);
        if (!has_next) break;
#pragma unroll
        for (int a = 0; a < 2; ++a)
#pragma unroll
            for (int b = 0; b < 2; ++b)
#pragma unroll
                for (int m = 0; m < 4; ++m)
#pragma unroll
                    for (int n = 0; n < 2; ++n) acc[a][b][m][n] = (f32x4){0.f, 0.f, 0.f, 0.f};
        cur = nxt; cA = nA; cB = nB; ++ui;
        if constexpr (ALIGN_EPI) { if (wr == 1) G8_BAR; }
    }
    G8_WAIT_V(0);
    if constexpr (!ALIGN_EPI) { if (wr == 0) G8_BAR; }
    G8_BAR;
#undef G8_SA
#undef G8_SB
#undef G8_STAGE
#undef G8_LDA
#undef G8_LDB
#undef G8_MMA
#undef G8_WAIT_V
#undef G8_WAIT_L
#undef G8_BAR
#undef G8_SCHED
}

struct ProbDense {
    static constexpr bool GATHER = false, HOOK = false;
    const char* A; const char* Bt; int K;
    __device__ __forceinline__ const char* a_base(const Unit& u) const { return A + (size_t)u.a * BM * K * 2; }
    __device__ __forceinline__ const char* b_base(const Unit& u) const { return Bt + (size_t)u.b * BM * K * 2; }
    __device__ __forceinline__ void fill_voffA(const Unit&, unsigned (&v)[2][2], int tid) const {
#pragma unroll
        for (int i = 0; i < 2; ++i) { int R, C; stage_rc(tid * 16 + i * 8192, R, C); v[0][i] = (unsigned)(R * K + C) * 2u; v[1][i] = (unsigned)((HALF + R) * K + C) * 2u; }
    }
    __device__ __forceinline__ void hook(f32x4 (&)[2][2][4][2], const Unit&, int, int, int, int) const {}
};
struct ProbWout {
    static constexpr bool GATHER = false, HOOK = true;
    const char* A; const char* Bt; int K; const float* headss;
    __device__ __forceinline__ const char* a_base(const Unit& u) const { return A + (size_t)u.a * BM * K * 2; }
    __device__ __forceinline__ const char* b_base(const Unit& u) const { return Bt + (size_t)u.b * BM * K * 2; }
    __device__ __forceinline__ void fill_voffA(const Unit&, unsigned (&v)[2][2], int tid) const {
#pragma unroll
        for (int i = 0; i < 2; ++i) { int R, C; stage_rc(tid * 16 + i * 8192, R, C); v[0][i] = (unsigned)(R * K + C) * 2u; v[1][i] = (unsigned)((HALF + R) * K + C) * 2u; }
    }
    __device__ __forceinline__ void hook(f32x4 (&acc)[2][2][4][2], const Unit& u, int wr, int wc, int fr, int fq) const {
#pragma unroll
        for (int ai = 0; ai < 2; ++ai)
#pragma unroll
            for (int m = 0; m < 4; ++m) {
                const int row = u.a * BM + ai * HALF + wr * 64 + m * 16 + fr;
                const f32x4* hp = (const f32x4*)(headss + (size_t)row * 16);
                const f32x4 a0 = hp[0], a1 = hp[1], b0 = hp[2], b1 = hp[3];
                const float sa = ((a0[0] + a0[1]) + (a0[2] + a0[3])) + ((a1[0] + a1[1]) + (a1[2] + a1[3]));
                const float sb = ((b0[0] + b0[1]) + (b0[2] + b0[3])) + ((b1[0] + b1[1]) + (b1[2] + b1[3]));
                const float ratio = rsqrtf(sa * (1.f / 512.f) + EPS) / rsqrtf(sb * (1.f / 512.f) + EPS);
#pragma unroll
                for (int bj = 0; bj < 2; ++bj)
#pragma unroll
                    for (int n = 0; n < 2; ++n) acc[ai][bj][m][n] *= ratio;
            }
    }
};
struct ProbMoe1 {
    static constexpr bool GATHER = true, HOOK = false;
    const char* A; const char* Bt; int K; const unsigned* list; const LAS int* cn;
    __device__ __forceinline__ const char* a_base(const Unit&) const { return A; }
    __device__ __forceinline__ const char* b_base(const Unit& u) const { return Bt + (size_t)(u.c * 4 + u.b) * BM * K * 2; }
    __device__ __forceinline__ void fill_voffA(const Unit& u, unsigned (&v)[2][2], int tid) const {
        const int n = cn[u.c];
#pragma unroll
        for (int i = 0; i < 2; ++i) { int R, C; stage_rc(tid * 16 + i * 8192, R, C);
#pragma unroll
            for (int h = 0; h < 2; ++h) { int idx = u.a * BM + h * HALF + R; idx = idx < n ? idx : n - 1;
                const unsigned ent = list[(size_t)u.c * T + idx];
                v[h][i] = (ent >> 1) * (unsigned)(K * 2) + (unsigned)C * 2u; } }
    }
    __device__ __forceinline__ void hook(f32x4 (&)[2][2][4][2], const Unit&, int, int, int, int) const {}
};
struct ProbMoe2 {
    static constexpr bool GATHER = false, HOOK = false;
    const char* A; const char* Bt; int K;
    __device__ __forceinline__ const char* a_base(const Unit& u) const { return A + (size_t)u.d * BM * K * 2; }
    __device__ __forceinline__ const char* b_base(const Unit& u) const { return Bt + ((size_t)u.c * 1024 + (size_t)u.b * BM) * K * 2; }
    __device__ __forceinline__ void fill_voffA(const Unit&, unsigned (&v)[2][2], int tid) const {
#pragma unroll
        for (int i = 0; i < 2; ++i) { int R, C; stage_rc(tid * 16 + i * 8192, R, C); v[0][i] = (unsigned)(R * K + C) * 2u; v[1][i] = (unsigned)((HALF + R) * K + C) * 2u; }
    }
    __device__ __forceinline__ void hook(f32x4 (&)[2][2][4][2], const Unit&, int, int, int, int) const {}
};

__device__ __forceinline__ u32x4 pack8(const f32x4 v0, const f32x4 v1) { u32x4 w; w.x = pk2(v0[0], v0[1]); w.y = pk2(v0[2], v0[3]); w.z = pk2(v1[0], v1[1]); w.w = pk2(v1[2], v1[3]); return w; }

struct EpiQkv {
    h16* out; const float* rowss0;
    __device__ __forceinline__ void operator()(const f32x4 (&acc)[2][2][4][2], const Unit& u, int wr, int wc, int fr, int fq) const {
        const float cs = (u.b < 2 || u.b == 6 || u.b == 7) ? QSCALE : 1.f;
#pragma unroll
        for (int ai = 0; ai < 2; ++ai)
#pragma unroll
            for (int m = 0; m < 4; ++m) { const int row = u.a * BM + ai * HALF + wr * 64 + m * 16 + fr;
                const float sc = rsqrtf(rowss0[row] * (1.f / 1024.f) + EPS) * cs;
                h16* rowp = out + (size_t)row * INW + u.b * BM + wc * 32 + 8 * fq;
#pragma unroll
                for (int bj = 0; bj < 2; ++bj) *(u32x4*)(rowp + bj * HALF) = pack8(acc[ai][bj][m][0] * sc, acc[ai][bj][m][1] * sc); }
    }
};
struct EpiPlain {
    h16* out; int ldc;
    __device__ __forceinline__ void operator()(const f32x4 (&acc)[2][2][4][2], const Unit& u, int wr, int wc, int fr, int fq) const {
#pragma unroll
        for (int ai = 0; ai < 2; ++ai)
#pragma unroll
            for (int m = 0; m < 4; ++m) { const int row = u.a * BM + ai * HALF + wr * 64 + m * 16 + fr;
                h16* rowp = out + (size_t)row * ldc + u.b * BM + wc * 32 + 8 * fq;
#pragma unroll
                for (int bj = 0; bj < 2; ++bj) *(u32x4*)(rowp + bj * HALF) = pack8(acc[ai][bj][m][0], acc[ai][bj][m][1]); }
    }
};
struct EpiWout {
    const float* x; h16* xmh; float* xss; const float* headss;
    __device__ __forceinline__ void operator()(const f32x4 (&acc)[2][2][4][2], const Unit& u, int wr, int wc, int fr, int fq) const {
#pragma unroll
        for (int ai = 0; ai < 2; ++ai)
#pragma unroll
            for (int m = 0; m < 4; ++m) { const int row = u.a * BM + ai * HALF + wr * 64 + m * 16 + fr;
                const f32x4* hp = (const f32x4*)(headss + (size_t)row * 16);
                const f32x4 b0 = hp[2], b1 = hp[3];
                const float sb = ((b0[0] + b0[1]) + (b0[2] + b0[3])) + ((b1[0] + b1[1]) + (b1[2] + b1[3]));
                const float rb = rsqrtf(sb * (1.f / 512.f) + EPS);
                const size_t off = (size_t)row * DM + u.b * BM + wc * 32 + 8 * fq; float ss = 0.f;
#pragma unroll
                for (int bj = 0; bj < 2; ++bj) { const f32x4 xa = *(const f32x4*)(x + off + bj * HALF), xb = *(const f32x4*)(x + off + bj * HALF + 4);
                    const f32x4 v0 = xa + acc[ai][bj][m][0] * rb, v1 = xb + acc[ai][bj][m][1] * rb;
                    *(u32x4*)(xmh + off + bj * HALF) = pack8(v0, v1);
                    ss += ((v0[0] * v0[0] + v0[1] * v0[1]) + (v0[2] * v0[2] + v0[3] * v0[3])) + ((v1[0] * v1[0] + v1[1] * v1[1]) + (v1[2] * v1[2] + v1[3] * v1[3])); }
                ss += __shfl_xor(ss, 16); ss += __shfl_xor(ss, 32);
                if (fq == 0) xss[(size_t)row * 16 + u.b * 4 + wc] = ss; }
    }
};
struct EpiMoe1 {
    h16* hid; const f32x2* rsw; const LAS int* cn;
    __device__ __forceinline__ void operator()(const f32x4 (&acc)[2][2][4][2], const Unit& u, int wr, int wc, int fr, int fq) const {
        const int nvalid = cn[u.c] - u.a * BM;
#pragma unroll
        for (int ai = 0; ai < 2; ++ai)
#pragma unroll
            for (int m = 0; m < 4; ++m) { const int lrow = ai * HALF + wr * 64 + m * 16 + fr;
                if (lrow < nvalid) {
                    const f32x2 rw = rsw[(size_t)u.c * T + u.a * BM + lrow];
                    f32x4 hv[2];
#pragma unroll
                    for (int n = 0; n < 2; ++n)
#pragma unroll
                        for (int j = 0; j < 4; ++j) { const float g = acc[ai][0][m][n][j] * rw.x, up = acc[ai][1][m][n][j] * rw.x;
                            hv[n][j] = g * __builtin_amdgcn_rcpf(1.f + __builtin_amdgcn_exp2f(-g * LOG2E)) * up * rw.y; }
                    *(u32x4*)(hid + (size_t)(u.d * BM + lrow) * DE + u.b * HALF + wc * 32 + 8 * fq) = pack8(hv[0], hv[1]); } }
    }
};
struct EpiMoe2 {
    h16* y; const unsigned* list; const LAS int* cn;
    __device__ __forceinline__ void operator()(const f32x4 (&acc)[2][2][4][2], const Unit& u, int wr, int wc, int fr, int fq) const {
        const int nvalid = cn[u.c] - u.a * BM;
#pragma unroll
        for (int ai = 0; ai < 2; ++ai)
#pragma unroll
            for (int m = 0; m < 4; ++m) { const int lrow = ai * HALF + wr * 64 + m * 16 + fr;
                if (lrow < nvalid) {
                    const unsigned ent = list[(size_t)u.c * T + u.a * BM + lrow];
                    h16* rowp = y + ((size_t)(ent & 1u) * T + (ent >> 1)) * DM + u.b * BM + wc * 32 + 8 * fq;
#pragma unroll
                    for (int bj = 0; bj < 2; ++bj) *(u32x4*)(rowp + bj * HALF) = pack8(acc[ai][bj][m][0], acc[ai][bj][m][1]); } }
    }
};
struct EpiPle {
    const h16* x2h; h16* x3h; const h16* pproj; const float* rowss3; float* xss3;
    __device__ __forceinline__ void operator()(const f32x4 (&acc)[2][2][4][2], const Unit& u, int wr, int wc, int fr, int fq) const {
#pragma unroll
        for (int ai = 0; ai < 2; ++ai)
#pragma unroll
            for (int m = 0; m < 4; ++m) { const int row = u.a * BM + ai * HALF + wr * 64 + m * 16 + fr;
                const float r3 = rsqrtf(rowss3[row] * (1.f / 1024.f) + EPS) * LOG2E;
                const size_t off = (size_t)row * DM + u.b * BM + wc * 32 + 8 * fq; float ss = 0.f;
#pragma unroll
                for (int bj = 0; bj < 2; ++bj) { const h16x8 xv = *(const h16x8*)(x2h + off + bj * HALF);
                    const h16x8 pp = *(const h16x8*)(pproj + off + bj * HALF);
                    f32x4 v0, v1;
#pragma unroll
                    for (int j = 0; j < 4; ++j) { const float g0 = __builtin_amdgcn_rcpf(1.f + __builtin_amdgcn_exp2f(-acc[ai][bj][m][0][j] * r3));
                        const float g1 = __builtin_amdgcn_rcpf(1.f + __builtin_amdgcn_exp2f(-acc[ai][bj][m][1][j] * r3));
                        v0[j] = (float)xv[j] + (float)pp[j] * g0; v1[j] = (float)xv[4 + j] + (float)pp[4 + j] * g1; }
                    *(u32x4*)(x3h + off + bj * HALF) = pack8(v0, v1);
                    ss += ((v0[0] * v0[0] + v0[1] * v0[1]) + (v0[2] * v0[2] + v0[3] * v0[3])) + ((v1[0] * v1[0] + v1[1] * v1[1]) + (v1[2] * v1[2] + v1[3] * v1[3])); }
                ss += __shfl_xor(ss, 16); ss += __shfl_xor(ss, 32);
                if (fq == 0) xss3[(size_t)row * 16 + u.b * 4 + wc] = ss; }
    }
};
}

namespace att {
__device__ __forceinline__ int crow(int r, int hi) { return (r & 3) + 8 * (r >> 2) + 4 * hi; }

struct TaskOut { f32x16 o[2]; float m, l; };

constexpr int KROW = 144, VOFF = 32 * KROW, WAVE_LDS = 9216;
template <int W  , int NQ>
__device__ __forceinline__ void run_task(const h16* proj, int tokbase, int dstr, int L, int i0, int qcol, int kcol, int vcol, float cslope,
                                         float m_init, float l_init, LAS unsigned char* kl, int lane, TaskOut (&R)[NQ]) {
    const int r32 = lane & 31, hi = lane >> 5;
    h16x8 qf[NQ][4];
    float m[NQ], l[NQ];
    f32x16 o0[NQ], o1[NQ];
#pragma unroll
    for (int j = 0; j < NQ; ++j) {
        const h16* qrow = proj + (size_t)(tokbase + dstr * (i0 + 32 * j + r32)) * INW + qcol + 8 * hi;
#pragma unroll
        for (int s = 0; s < 4; ++s) qf[j][s] = *(const h16x8*)(qrow + 16 * s);
        m[j] = m_init; l[j] = l_init; o0[j] = (f32x16){}; o1[j] = (f32x16){};
    }
    int kt_lo = -(i0 >> 5); kt_lo = kt_lo < -W ? -W : kt_lo;
    int kt_hi = (L - 32 - i0) >> 5; kt_hi = kt_hi > W + NQ - 1 ? W + NQ - 1 : kt_hi;
    kt_lo = __builtin_amdgcn_readfirstlane(kt_lo); kt_hi = __builtin_amdgcn_readfirstlane(kt_hi);
    const int wkey = lane >> 3, wch = lane & 7;
    LAS unsigned char* kw = kl + wkey * KROW + wch * 16;
    LAS unsigned char* vw = kl + VOFF + (wch >> 2) * 2048 + wkey * 64 + (wch & 3) * 16;
    const LAS unsigned char* kr = kl + r32 * KROW + 16 * hi;
    const int g = lane >> 4, q4 = (lane & 15) >> 2, p4 = lane & 3;
    LAS unsigned char* vr = kl + VOFF + (4 * (g >> 1) + q4) * 64 + (16 * (g & 1) + 4 * p4) * 2;
    h16x8 kraw[4], vraw[4];
    {
        const int k0 = i0 + 32 * kt_lo;
#pragma unroll
        for (int i = 0; i < 4; ++i) { const h16* row = proj + (size_t)(tokbase + dstr * (k0 + 8 * i + wkey)) * INW + 8 * wch;
            kraw[i] = *(const h16x8*)(row + kcol); vraw[i] = *(const h16x8*)(row + vcol); }
    }
    for (int kt = kt_lo; kt <= kt_hi; ++kt) {
        asm volatile("" ::: "memory");
#pragma unroll
        for (int i = 0; i < 4; ++i) { *(LAS h16x8*)(kw + i * 8 * KROW) = kraw[i]; *(LAS h16x8*)(vw + i * 512) = vraw[i]; }
        asm volatile("" ::: "memory");
        if (kt < kt_hi) {
            const int k0 = i0 + 32 * (kt + 1);
#pragma unroll
            for (int i = 0; i < 4; ++i) { const h16* row = proj + (size_t)(tokbase + dstr * (k0 + 8 * i + wkey)) * INW + 8 * wch;
                kraw[i] = *(const h16x8*)(row + kcol); vraw[i] = *(const h16x8*)(row + vcol); }
        }
        h16x8 kf[4];
#pragma unroll
        for (int s = 0; s < 4; ++s) kf[s] = *(const LAS h16x8*)(kr + 32 * s);
#define ATT_VTR(n, s, b) __builtin_amdgcn_ds_read_tr16_b64_v4i16((LAS v4i16_t*)(vr + (n) * 2048 + (s) * 1024 + (b) * 512))
        const v4i16_t a00 = ATT_VTR(0, 0, 0), a01 = ATT_VTR(0, 0, 1), a10 = ATT_VTR(0, 1, 0), a11 = ATT_VTR(0, 1, 1);
        const v4i16_t b00 = ATT_VTR(1, 0, 0), b01 = ATT_VTR(1, 0, 1), b10 = ATT_VTR(1, 1, 0), b11 = ATT_VTR(1, 1, 1);
#undef ATT_VTR
        asm volatile("" ::: "memory");
#define ATT_CAT(x, y) __builtin_bit_cast(h16x8, (s16x8){x[0], x[1], x[2], x[3], y[0], y[1], y[2], y[3]})
        const h16x8 va0 = ATT_CAT(a00, a01), va1 = ATT_CAT(a10, a11), vb0 = ATT_CAT(b00, b01), vb1 = ATT_CAT(b10, b11);
#undef ATT_CAT
#pragma unroll
        for (int j = 0; j < NQ; ++j) {
            const int ktj = kt - j;
            if (ktj >= -W && ktj <= W) {
                f32x16 st = {};
#pragma unroll
                for (int s = 0; s < 4; ++s) st = __builtin_amdgcn_mfma_f32_32x32x16_f16(kf[s], qf[j][s], st, 0, 0, 0);
                const float relb = (float)(32 * ktj + 4 * hi - r32);
                float mx = -1e30f;
                const bool edge = (ktj == -W) || (ktj == W);
#pragma unroll
                for (int r = 0; r < 16; ++r) { const float rel = fabsf(relb + (float)((r & 3) + 8 * (r >> 2)));
                    float sv = st[r] - cslope * rel;
                    if (edge) sv = (rel > (float)(32 * W)) ? -1e30f : sv;
                    st[r] = sv; mx = fmaxf(mx, sv); }
                mx = xhalf_max(mx);
                const float mn = fmaxf(m[j], mx);
                const float alpha = __builtin_amdgcn_exp2f(m[j] - mn);
                m[j] = mn;
                float rs = 0.f;
#pragma unroll
                for (int r = 0; r < 16; ++r) { const float pv = __builtin_amdgcn_exp2f(st[r] - mn); st[r] = pv; rs += pv; }
                l[j] = l[j] * alpha + rs;
                if (__any(alpha != 1.f)) {
#pragma unroll
                    for (int r = 0; r < 16; ++r) { o0[j][r] *= alpha; o1[j][r] *= alpha; } }
                u32x4 pw0, pw1;
                pw0.x = pk2(st[0], st[1]); pw0.y = pk2(st[2], st[3]); pw0.z = pk2(st[4], st[5]); pw0.w = pk2(st[6], st[7]);
                pw1.x = pk2(st[8], st[9]); pw1.y = pk2(st[10], st[11]); pw1.z = pk2(st[12], st[13]); pw1.w = pk2(st[14], st[15]);
                const h16x8 pf0 = __builtin_bit_cast(h16x8, pw0), pf1 = __builtin_bit_cast(h16x8, pw1);
                o0[j] = __builtin_amdgcn_mfma_f32_32x32x16_f16(va0, pf0, o0[j], 0, 0, 0);
                o0[j] = __builtin_amdgcn_mfma_f32_32x32x16_f16(va1, pf1, o0[j], 0, 0, 0);
                o1[j] = __builtin_amdgcn_mfma_f32_32x32x16_f16(vb0, pf0, o1[j], 0, 0, 0);
                o1[j] = __builtin_amdgcn_mfma_f32_32x32x16_f16(vb1, pf1, o1[j], 0, 0, 0);
            }
        }
    }
#pragma unroll
    for (int j = 0; j < NQ; ++j) { R[j].o[0] = o0[j]; R[j].o[1] = o1[j]; R[j].m = m[j]; R[j].l = xhalf_sum(l[j]); }
}

__device__ __forceinline__ float store_o(const TaskOut& R, float inv, h16* dst, int hi) {
    float ss = 0.f;
#pragma unroll
    for (int n = 0; n < 2; ++n)
#pragma unroll
        for (int g = 0; g < 4; ++g) { const float a = R.o[n][4 * g] * inv, b = R.o[n][4 * g + 1] * inv, c = R.o[n][4 * g + 2] * inv, d = R.o[n][4 * g + 3] * inv;
            ss += (a * a + b * b) + (c * c + d * d);
            u32x2 w; w.x = pk2(a, b); w.y = pk2(c, d); *(u32x2*)(dst + 32 * n + 8 * g + 4 * hi) = w; }
    return ss;
}

__device__ __forceinline__ void a_store(const TaskOut& R, h16* oc, float* lsec, int c, int tok, int h, int hi) {
    (void)store_o(R, 1.f / R.l, oc + ((size_t)c * T + tok) * 512 + h * 64, hi);
    if (hi == 0) lsec[((size_t)c * T + tok) * 8 + h] = R.m + __builtin_amdgcn_logf(R.l);
}
__device__ __forceinline__ void unit_a(const h16* proj, h16* oc, float* lsec, h16* o, float* headss, int b, int h, int blk, LAS unsigned char* kl, int wid, int lane) {
    const int r32 = lane & 31, hi = lane >> 5;
    const float slope = __builtin_amdgcn_exp2f(-(float)(h + 1));
#pragma unroll 1
    for (int c = 0; c < 2; ++c) {
        const int dsh = 2 * c, d = 1 << dsh;
        const int res = c ? (wid >> 1) : 0, pr = c ? (wid & 1) : wid;
        const int L = SEQ >> dsh, i0 = blk * (512 >> dsh) + 64 * pr;
        TaskOut R[2];
        run_task<2, 2>(proj, b * SEQ + res, d, L, i0, h * 64, 512 + h * 64, 1024 + h * 64, slope * (float)d * LOG2E, -1e30f, 0.f, kl, lane, R);
#pragma unroll
        for (int j = 0; j < 2; ++j) a_store(R[j], oc, lsec, c, b * SEQ + res + d * (i0 + 32 * j + r32), h, hi);
    }
#pragma unroll 1
    for (int k = 0; k < 2; ++k) {
        const int res = wid + 8 * k, i0 = blk * 32;
        TaskOut R[1];
        run_task<2, 1>(proj, b * SEQ + res, 16, SEQ / 16, i0, h * 64, 512 + h * 64, 1024 + h * 64, slope * 16.f * LOG2E, -1e30f, 0.f, kl, lane, R);
        a_store(R[0], oc, lsec, 2, b * SEQ + res + 16 * (i0 + r32), h, hi);
    }
    __syncthreads();
    {
        const int tbase = b * SEQ + blk * 512 + wid * 64 + (lane >> 3), ch = lane & 7;
        float lg[8][3]; h16x8 vv[8][3];
#pragma unroll
        for (int it = 0; it < 8; ++it) { const int tok = tbase + 8 * it;
#pragma unroll
            for (int c = 0; c < 3; ++c) { lg[it][c] = lsec[((size_t)c * T + tok) * 8 + h]; vv[it][c] = *(const h16x8*)(oc + ((size_t)c * T + tok) * 512 + h * 64 + ch * 8); } }
#pragma unroll
        for (int it = 0; it < 8; ++it) { const int tok = tbase + 8 * it;
            const float mx = fmaxf(lg[it][0], fmaxf(lg[it][1], lg[it][2]));
            const float w0 = __builtin_amdgcn_exp2f(lg[it][0] - mx), w1 = __builtin_amdgcn_exp2f(lg[it][1] - mx), w2 = __builtin_amdgcn_exp2f(lg[it][2] - mx);
            const float inv = 1.f / (w0 + w1 + w2);
            float ov[8]; float ss = 0.f;
#pragma unroll
            for (int e = 0; e < 8; ++e) { ov[e] = (w0 * (float)vv[it][0][e] + w1 * (float)vv[it][1][e] + w2 * (float)vv[it][2][e]) * inv; ss += ov[e] * ov[e]; }
            u32x4 w; w.x = pk2(ov[0], ov[1]); w.y = pk2(ov[2], ov[3]); w.z = pk2(ov[4], ov[5]); w.w = pk2(ov[6], ov[7]);
            *(u32x4*)(o + (size_t)tok * DM + h * 64 + ch * 8) = w;
            ss += __shfl_xor(ss, 1); ss += __shfl_xor(ss, 2); ss += __shfl_xor(ss, 4);
            if (ch == 0) headss[(size_t)tok * 16 + h] = ss; }
    }
}
__device__ __forceinline__ void unit_b(const h16* proj, const float* sink, h16* o, float* headss, int b, int hq, int blk, LAS unsigned char* kl, int wid, int lane) {
    const int r32 = lane & 31, hi = lane >> 5, hk = hq >> 2;
    const float slope = __builtin_amdgcn_exp2f(-(float)(hq + 1));
    const float sk = sink[hq] * LOG2E;
    const int i0 = blk * 512 + 64 * wid;
    TaskOut R[2];
    run_task<4, 2>(proj, b * SEQ, 1, SEQ, i0, 1536 + hq * 64, 2048 + hk * 64, 2176 + hk * 64, slope * LOG2E, sk, hi == 0 ? 1.f : 0.f, kl, lane, R);
#pragma unroll
    for (int j = 0; j < 2; ++j) {
        const int tok = b * SEQ + i0 + 32 * j + r32;
        float ss = store_o(R[j], 1.f / R[j].l, o + (size_t)tok * DM + 512 + hq * 64, hi);
        ss = xhalf_sum(ss);
        if (hi == 0) headss[(size_t)tok * 16 + 8 + hq] = ss;
    }
}
}

#define XB_TMO      128
#define XB_XCNT(j)  (256  + 64 * (j))
#define XB_XSUB(j)  (1280 + 64 * (j))
#define XB_XGEN(j)  (2304 + 64 * (j))
#define XB_TOP      3328
#define XB_TOPGEN   3392
#define XCD_BAR_WORDS 3456
#define XB_SPIN_CAP (1u << 20)
__device__ __forceinline__ unsigned xb_ld(unsigned* p)              { return __hip_atomic_load(p, __ATOMIC_RELAXED, __HIP_MEMORY_SCOPE_AGENT); }
__device__ __forceinline__ unsigned xb_add(unsigned* p, unsigned v) { return __hip_atomic_fetch_add(p, v, __ATOMIC_RELAXED, __HIP_MEMORY_SCOPE_AGENT); }
__device__ __forceinline__ unsigned xb_xcc_id() { return (unsigned)__builtin_amdgcn_s_getreg((3 << 11) | 20) & 0xFu; }
#define XB_SPIN(cond, bar) do { unsigned _sp = 0; while (cond) { __builtin_amdgcn_s_sleep(1); \
    if ((++_sp & 255u) == 0u) { if (xb_ld(&(bar)[XB_TMO])) break; if (_sp > XB_SPIN_CAP) { atomicAdd(&(bar)[XB_TMO], 1u); break; } } } } while (0)
struct XcdBarrier { unsigned* bar; unsigned x; volatile LAS unsigned* st; };
__device__ __forceinline__ XcdBarrier xcd_barrier_post(unsigned* bar, volatile LAS unsigned* st) {
    XcdBarrier b; b.bar = bar; b.x = xb_xcc_id(); b.st = st;
    if (threadIdx.x == 0) (void)xb_add(&bar[XB_XCNT(b.x)], 1u);
    return b;
}
__device__ __forceinline__ void xcd_barrier_complete(unsigned* bar, unsigned x, unsigned& nloc, unsigned& nx) {
    const unsigned G = gridDim.x * gridDim.y * gridDim.z;
    unsigned sum, cnt, mine, sp = 0u;
    for (;;) {
        sum = 0u; cnt = 0u; mine = 0u;
#pragma unroll
        for (unsigned j = 0; j < 16; ++j) { const unsigned c = xb_ld(&bar[XB_XCNT(j)]); sum += c; cnt += (c > 0u) ? 1u : 0u; mine = (j == x) ? c : mine; }
        if (sum == G) break;
        __builtin_amdgcn_s_sleep(1);
        if ((++sp & 255u) == 0u) { if (xb_ld(&bar[XB_TMO])) break; if (sp > XB_SPIN_CAP) { atomicAdd(&bar[XB_TMO], 1u); break; } }
    }
    nloc = mine > 0u ? mine : 1u; nx = cnt > 0u ? cnt : 1u;
}
__device__ __forceinline__ void xcd_barrier(const XcdBarrier& b) {
    asm volatile("s_waitcnt vmcnt(0)" ::: "memory");
    __syncthreads();
    if (threadIdx.x == 0) {
        unsigned* bar = b.bar;
        __builtin_amdgcn_s_waitcnt(0);
        unsigned nloc = b.st[0], nx = b.st[1];
        if (nloc == 0u) { xcd_barrier_complete(bar, b.x, nloc, nx); b.st[0] = nloc; b.st[1] = nx; }
        const unsigned old = xb_add(&bar[XB_XSUB(b.x)], 1u);
        const unsigned gen = old / nloc;
        if (old + 1u == (gen + 1u) * nloc) {
            __builtin_amdgcn_fence(__ATOMIC_RELEASE, "agent");
            asm volatile("s_waitcnt vmcnt(0)" ::: "memory");
            const unsigned og = xb_add(&bar[XB_TOP], 1u);
            const unsigned tg = og / nx;
            if (og + 1u == (tg + 1u) * nx) xb_add(&bar[XB_TOPGEN], 1u);
            else XB_SPIN(xb_ld(&bar[XB_TOPGEN]) == tg, bar);
            __builtin_amdgcn_fence(__ATOMIC_ACQUIRE, "agent");
            xb_add(&bar[XB_XGEN(b.x)], 1u);
            asm volatile("s_waitcnt vmcnt(0)" ::: "memory");
        } else {
            XB_SPIN(xb_ld(&bar[XB_XGEN(b.x)]) == gen, bar);
            __builtin_amdgcn_fence(__ATOMIC_ACQUIRE, "agent");
            asm volatile("s_waitcnt vmcnt(0)" ::: "memory");
        }
    }
    __syncthreads();
}

constexpr int NWAVES = 8;
constexpr int NPH = 10;
struct Args { const float* in[20]; float* out; unsigned char* ws; int ph_lo, ph_hi, li, pad; };

__device__ __forceinline__ void p0_item64(const float* W, int ldw, int k0, int n0, h16* dst, int Kd, int drow0, const float* gain, int lane) {
    const int kq = lane >> 4, nq = lane & 15;
    f32x4 v[16];
    const float* src = W + (size_t)(k0 + 16 * kq) * ldw + n0 + 4 * nq;
#pragma unroll
    for (int i = 0; i < 16; ++i) v[i] = *(const f32x4*)(src + (size_t)i * ldw);
    f32x4 g[4];
#pragma unroll
    for (int i = 0; i < 4; ++i) g[i] = gain ? *(const f32x4*)(gain + k0 + 16 * kq + 4 * i) : (f32x4){1.f, 1.f, 1.f, 1.f};
#pragma unroll
    for (int i = 0; i < 4; ++i)
#pragma unroll
        for (int e = 0; e < 4; ++e) v[4 * i + e] *= g[i][e];
#pragma unroll
    for (int jn = 0; jn < 4; ++jn) {
        h16* drow = dst + (size_t)(drow0 + 4 * nq + jn) * Kd + k0 + 16 * kq;
#pragma unroll
        for (int hh = 0; hh < 2; ++hh) {
            u32x4 o; o.x = pk2(v[8 * hh][jn], v[8 * hh + 1][jn]); o.y = pk2(v[8 * hh + 2][jn], v[8 * hh + 3][jn]);
            o.z = pk2(v[8 * hh + 4][jn], v[8 * hh + 5][jn]); o.w = pk2(v[8 * hh + 6][jn], v[8 * hh + 7][jn]);
            *(u32x4*)(drow + 8 * hh) = o;
        }
    }
}

__global__ void __launch_bounds__(NWAVES * 64, 2) mk_fwd(Args args) {
    extern __shared__ __attribute__((aligned(16))) unsigned char lds_raw[];
    LAS unsigned char* lds = (LAS unsigned char*)lds_raw;
    const int tid = threadIdx.x, lane = tid & 63, wid = __builtin_amdgcn_readfirstlane(tid >> 6);
    const int G = gridDim.x, bx = blockIdx.x;
    const int vcu = (G % 8 == 0) ? (bx % 8) * (G / 8) + bx / 8 : bx;
    unsigned char* ws = args.ws;
    unsigned* ctl = (unsigned*)(ws + WS_CTL);
    const float* x = args.in[0]; const float* pin = args.in[1]; const float* g_mix = args.in[2]; const float* w_in = args.in[3];
    const float* sink = args.in[4]; const float* g_ga = args.in[5]; const float* g_gb = args.in[6]; const float* w_out = args.in[7];
    const float* g_ffn = args.in[8]; const float* wrg = args.in[9]; const float* brg = args.in[10]; const float* wre = args.in[11];
    const float* bre = args.in[12]; const float* wg = args.in[13]; const float* wu = args.in[14]; const float* wd = args.in[15];
    const float* g_ple = args.in[16]; const float* wpg = args.in[17]; const float* wpp = args.in[18]; const float* g_fin = args.in[19];
    float* out = args.out;
    h16* Win_t = (h16*)(ws + WS_WIN); h16* Wout_t = (h16*)(ws + WS_WOUT); h16* Wr_t = (h16*)(ws + WS_WR); h16* Wpg_t = (h16*)(ws + WS_WPG); h16* Wpp_t = (h16*)(ws + WS_WPP);
    h16* Wd_t = (h16*)(ws + WS_WD); h16* Wgu_t = (h16*)(ws + WS_WGU); h16* Yb = (h16*)(ws + WS_Y);
    h16* proj = (h16*)(ws + WS_PROJ); h16* xmh = (h16*)(ws + WS_XMH); h16* x2h = (h16*)(ws + WS_X2H); h16* hid = (h16*)(ws + WS_HID);
    h16* xh = (h16*)(ws + WS_XH); h16* ob = (h16*)(ws + WS_O); h16* pproj = (h16*)(ws + WS_PPROJ); h16* ph = (h16*)(ws + WS_PH);
    float* rowss0 = (float*)(ws + WS_ROWSS0); float* headss = (float*)(ws + WS_HEADSS); float* lsec = (float*)(ws + WS_LSEC); float* xss = (float*)(ws + WS_XSS);
    unsigned* list = (unsigned*)(ws + WS_LIST); f32x2* rsw = (f32x2*)(ws + WS_RSW); float* rowss3 = (float*)(ws + WS_ROWSS3); float* xss3 = (float*)(ws + WS_XSS3);
    h16* oc = (h16*)out; h16* x3h = (h16*)(ws + WS_HID);
    LAS int* gt = (LAS int*)(lds + MOE_GT_OFF); LAS int* cn = (LAS int*)(lds + MOE_CN_OFF);

    for (int u = tid; u < (LDS_BYTES - LDSCTL_OFF) / 4; u += NWAVES * 64) ((LAS unsigned*)(lds + LDSCTL_OFF))[u] = 0u;
    __syncthreads();
    XcdBarrier bar; bar.bar = ctl + CW_BAR + args.li * XCD_BAR_WORDS; bar.x = 0; bar.st = nullptr;
    const int lo = args.ph_lo, hi = args.ph_hi;
    if (hi - lo > 1) bar = xcd_barrier_post(ctl + CW_BAR + args.li * XCD_BAR_WORDS, (volatile LAS unsigned*)(lds + MISC_OFF));
#define IN(k) (lo <= (k) && (k) < hi)
#define SEAM(k) do { if (IN(k) && IN((k) + 1)) { xcd_barrier(bar); if (MK_DUP == 20) xcd_barrier(bar); } if (MK_STAMP >= 0 && threadIdx.x == 0) stamps[(k) + 1] = __builtin_amdgcn_s_memrealtime(); } while (0)
    if (MK_STAMP >= 0 && threadIdx.x == 0) stamps[0] = __builtin_amdgcn_s_memrealtime();
    const int gw = vcu * NWAVES + wid, NGW = G * NWAVES;

    if (IN(0)) REPS(0) {
        constexpr int I_IN = 16 * 36, I_OUT = 16 * 16, I_PG = 16 * 16, I_PP = 4 * 16, I_GU = NE * 2 * 16 * 8, I_D = NE * 8 * 16;
        constexpr int NITEMS = I_IN + I_OUT + I_PG + I_PP + I_GU + I_D;
        for (int it = gw; it < NITEMS; it += NGW) {
            int r = it;
            if (r < I_IN) { const int kb = r / 36, nb = r % 36; p0_item64(w_in, INW, 64 * kb, 64 * nb, Win_t, DM, 64 * nb, g_mix, lane); continue; } r -= I_IN;
            if (r < I_OUT) { const int kb = r / 16, nb = r % 16; p0_item64(w_out, DM, 64 * kb, 64 * nb, Wout_t, DM, 64 * nb, kb < 8 ? g_ga : g_gb - 512, lane); continue; } r -= I_OUT;
            if (r < I_PG) { const int kb = r / 16, nb = r % 16; p0_item64(wpg, DM, 64 * kb, 64 * nb, Wpg_t, DM, 64 * nb, g_ple, lane); continue; } r -= I_PG;
            if (r < I_PP) { const int kb = r / 16, nb = r % 16; p0_item64(wpp, DM, 64 * kb, 64 * nb, Wpp_t, PLE, 64 * nb, nullptr, lane); continue; } r -= I_PP;
            if (r < I_GU) { const int e = r / 256, q = r % 256, isup = q / 128, q2 = q % 128, kb = q2 / 8, nb = q2 % 8;
                const float* src = (isup ? wu : wg) + (size_t)e * DM * DE;
                h16* dst = Wgu_t + (size_t)e * 4 * 256 * DM;
                p0_item64(src, DE, 64 * kb, 64 * nb, dst, DM, (nb >> 1) * 256 + isup * 128 + (nb & 1) * 64, g_ffn, lane); continue; } r -= I_GU;
            { const int e = r / 128, q = r % 128, kb = q / 16, nb = q % 16;
                p0_item64(wd + (size_t)e * DE * DM, DM, 64 * kb, 64 * nb, Wd_t + (size_t)e * DM * DE, DE, 64 * nb, nullptr, lane); }
        }
        for (int i = bx * 512 + tid; i < 48 * DM; i += G * 512) { const int n = i / DM, k = i % DM;
            float v = 0.f; if (n < 4) v = wrg[k * 4 + n]; else if (n < 36) v = wre[k * 32 + (n - 4)];
            Wr_t[i] = (h16)(v * g_ffn[k]); }
        for (int m0 = gw * 4; m0 < T; m0 += NGW * 4) {
            f32x4 v[4][4];
#pragma unroll
            for (int q = 0; q < 4; ++q) { const f32x4* xr = (const f32x4*)(x + (size_t)(m0 + q) * DM) + lane;
#pragma unroll
                for (int j = 0; j < 4; ++j) v[q][j] = xr[64 * j]; }
#pragma unroll
            for (int q = 0; q < 4; ++q) { float s = 0.f; unsigned long long* o8 = (unsigned long long*)(xh + (size_t)(m0 + q) * DM) + lane;
#pragma unroll
                for (int j = 0; j < 4; ++j) { const f32x4 w = v[q][j]; s += (w[0] * w[0] + w[1] * w[1]) + (w[2] * w[2] + w[3] * w[3]);
                    o8[64 * j] = (unsigned long long)pk2(w[0], w[1]) | ((unsigned long long)pk2(w[2], w[3]) << 32); }
                s = wave_sum(s); if (lane == 0) rowss0[m0 + q] = s; }
        }
        for (int i0 = (bx * 512 + tid) * 4; i0 < T * PLE / 4; i0 += G * 512 * 4) { f32x4 v[4];
#pragma unroll
            for (int q = 0; q < 4; ++q) v[q] = ((const f32x4*)pin)[i0 + q];
            u32x4 o0, o1; o0.x = pk2(v[0][0], v[0][1]); o0.y = pk2(v[0][2], v[0][3]); o0.z = pk2(v[1][0], v[1][1]); o0.w = pk2(v[1][2], v[1][3]);
            o1.x = pk2(v[2][0], v[2][1]); o1.y = pk2(v[2][2], v[2][3]); o1.z = pk2(v[3][0], v[3][1]); o1.w = pk2(v[3][2], v[3][3]);
            ((u32x4*)ph)[(i0 >> 1)] = o0; ((u32x4*)ph)[(i0 >> 1) + 1] = o1; }
    }
    SEAM(0);
    if (IN(1)) {
        { g8::ProbDense P{(const char*)xh, (const char*)Win_t, DM}; g8::StaticOrder S; S.init(T, INW, G, bx); if (MK_DUP == 1) S.dup = 2;
          g8::EpiQkv E{proj, rowss0};
          g8::gemm_phase<g8::ProbDense, g8::EpiQkv, g8::StaticOrder, true>(lds, P, S, E); }
        { g8::ProbDense P{(const char*)ph, (const char*)Wpp_t, PLE}; g8::StaticOrder S; S.init(T, DM, G, bx); if (MK_DUP == 11) S.dup = 2;
          g8::EpiPlain E{pproj, DM};
          g8::gemm_phase<g8::ProbDense, g8::EpiPlain, g8::StaticOrder, true>(lds, P, S, E); }
    }
    SEAM(1);
    if (IN(2)) REPS(2) {
        LAS unsigned char* vl = lds + wid * att::WAVE_LDS;
        for (int u = vcu; u < 256; u += G) { const int b = u >> 6, h = (u >> 3) & 7, blk = u & 7;
            att::unit_a(proj, oc, lsec, ob, headss, b, h, blk, vl, wid, lane); }
        for (int u = vcu; u < 256; u += G) { const int b = u >> 6, hq = (u >> 3) & 7, blk = u & 7;
            att::unit_b(proj, sink, ob, headss, b, hq, blk, vl, wid, lane); }
    }
    SEAM(2);
    if (IN(3)) {
        g8::ProbWout P{(const char*)ob, (const char*)Wout_t, DM, headss}; g8::StaticOrder S; S.init(T, DM, G, bx); if (MK_DUP == 3) S.dup = 2;
        g8::EpiWout E{x, xmh, xss, headss};
        g8::gemm_phase<g8::ProbWout, g8::EpiWout, g8::StaticOrder, true>(lds, P, S, E);
    }
    SEAM(3);
    if (IN(4)) {
        LAS float* lg = (LAS float*)(lds + wid * 4096);
        LAS unsigned* hist = (LAS unsigned*)(lds + 65536);
        const int fr = lane & 15, fq = lane >> 4;
        for (int tb0 = 0; tb0 < T / 16; tb0 += 4 * G) {
            const int tb = tb0 + wid * G + vcu;
            const bool active = (wid < 4) && (tb < T / 16);
            if (tid < 64) hist[tid] = 0u;
            __syncthreads();
            int e0 = 0, e1i = 0; float wt0 = 0.f, wt1 = 0.f, r2 = 0.f; unsigned rk0 = 0u, rk1 = 0u;
            if (active) {
                const int tok = tb * 16 + fr;
                f32x4 a0 = {0.f, 0.f, 0.f, 0.f}, a1 = a0, a2 = a0;
                const h16* xr = xmh + (size_t)tok * DM + 8 * fq;
                const h16* w0 = Wr_t + (size_t)fr * DM + 8 * fq;
#pragma unroll 8
                for (int k0 = 0; k0 < DM; k0 += 32) {
                    const h16x8 bx8 = *(const h16x8*)(xr + k0);
                    const h16x8 wa = *(const h16x8*)(w0 + k0), wb = *(const h16x8*)(w0 + 16 * DM + k0), wc8 = *(const h16x8*)(w0 + 32 * DM + k0);
                    a0 = __builtin_amdgcn_mfma_f32_16x16x32_f16(wa, bx8, a0, 0, 0, 0);
                    a1 = __builtin_amdgcn_mfma_f32_16x16x32_f16(wb, bx8, a1, 0, 0, 0);
                    a2 = __builtin_amdgcn_mfma_f32_16x16x32_f16(wc8, bx8, a2, 0, 0, 0);
                }
                asm volatile("" ::: "memory");
#pragma unroll
                for (int j = 0; j < 4; ++j) { lg[fr * 48 + 4 * fq + j] = a0[j]; lg[fr * 48 + 16 + 4 * fq + j] = a1[j]; lg[fr * 48 + 32 + 4 * fq + j] = a2[j]; }
                asm volatile("" ::: "memory");
                LDS_WAIT();
                if (lane < 16) {
                    const int t = tb * 16 + lane;
                    const f32x4* sp = (const f32x4*)(xss + (size_t)t * 16);
                    const f32x4 s0 = sp[0], s1 = sp[1], s2 = sp[2], s3 = sp[3];
                    const float ssum = (((s0[0] + s0[1]) + (s0[2] + s0[3])) + ((s1[0] + s1[1]) + (s1[2] + s1[3]))) + (((s2[0] + s2[1]) + (s2[2] + s2[3])) + ((s3[0] + s3[1]) + (s3[2] + s3[3])));
                    r2 = rsqrtf(ssum * (1.f / 1024.f) + EPS);
                    const LAS float* ll = lg + lane * 48;
                    float gl[4];
#pragma unroll
                    for (int i = 0; i < 4; ++i) gl[i] = ll[i] * r2 + brg[i];
                    int gs = 0; float gm = gl[0];
#pragma unroll
                    for (int i = 1; i < 4; ++i) if (gl[i] > gm) { gm = gl[i]; gs = i; }
                    float den = 0.f;
#pragma unroll
                    for (int i = 0; i < 4; ++i) den += __expf(gl[i] - gm);
                    const float gwt = 1.f / den;
                    float v0 = -3e38f, v1 = -3e38f; int i0 = 0, i1 = 0;
#pragma unroll
                    for (int i = 0; i < 8; ++i) { const float v = ll[4 + gs * 8 + i] * r2 + bre[gs * 8 + i];
                        if (v > v0) { v1 = v0; i1 = i0; v0 = v; i0 = i; } else if (v > v1) { v1 = v; i1 = i; } }
                    const float ex1 = __expf(v1 - v0);
                    wt0 = gwt / (1.f + ex1); wt1 = gwt * ex1 / (1.f + ex1);
                    e0 = gs * 8 + i0; e1i = gs * 8 + i1;
                    rk0 = atomicAdd((unsigned*)(hist + e0), 1u);
                    rk1 = atomicAdd((unsigned*)(hist + e1i), 1u);
                }
            }
            __syncthreads();
            if (tid < 32) { const unsigned c = hist[tid]; hist[32 + tid] = c ? atomicAdd(ctl + CW_CNT + 64 * tid, c) : 0u; }
            __syncthreads();
            if (active && lane < 16) {
                const int t = tb * 16 + lane;
                const unsigned p0 = hist[32 + e0] + rk0, p1 = hist[32 + e1i] + rk1;
                list[(size_t)e0 * T + p0] = (unsigned)t * 2u; rsw[(size_t)e0 * T + p0] = (f32x2){r2, wt0};
                list[(size_t)e1i * T + p1] = (unsigned)t * 2u + 1u; rsw[(size_t)e1i * T + p1] = (f32x2){r2, wt1};
            }
            __syncthreads();
        }
    }
    SEAM(4);
    if (IN(5) || IN(6)) {
        if (tid < 32) cn[tid] = (int)__hip_atomic_load(ctl + CW_CNT + 64 * tid, RLX_AGENT);
        __syncthreads();
        if (tid == 0) { int s = 0; for (int e = 0; e < 32; ++e) { gt[e] = s; s += (cn[e] + 255) >> 8; } gt[32] = s; }
        __syncthreads();
    }
    if (IN(5)) REPS(5) {
        g8::ProbMoe1 P{(const char*)xmh, (const char*)Wgu_t, DM, list, cn}; g8::MoeOrder S{G, vcu, gt};
        g8::EpiMoe1 E{hid, rsw, cn};
        g8::gemm_phase<g8::ProbMoe1, g8::EpiMoe1, g8::MoeOrder, true>(lds, P, S, E);
    }
    SEAM(5);
    if (IN(6)) REPS(6) {
        g8::ProbMoe2 P{(const char*)hid, (const char*)Wd_t, DE}; g8::MoeOrder S{G, vcu, gt};
        g8::EpiMoe2 E{Yb, list, cn};
        g8::gemm_phase<g8::ProbMoe2, g8::EpiMoe2, g8::MoeOrder, true>(lds, P, S, E);
    }
    SEAM(6);
    if (IN(7)) {
        for (int m0 = gw * 4; m0 < T; m0 += NGW * 4) {
            u32x4 xa[4][2], ya[4][2], yb[4][2];
#pragma unroll
            for (int q = 0; q < 4; ++q) { const int m = m0 + q;
                const u32x4* xr = (const u32x4*)(xmh + (size_t)m * DM) + lane; const u32x4* y0 = (const u32x4*)(Yb + (size_t)m * DM) + lane; const u32x4* y1 = (const u32x4*)(Yb + ((size_t)T + m) * DM) + lane;
#pragma unroll
                for (int j = 0; j < 2; ++j) { xa[q][j] = xr[64 * j]; ya[q][j] = y0[64 * j]; yb[q][j] = y1[64 * j]; } }
#pragma unroll
            for (int q = 0; q < 4; ++q) { const int m = m0 + q; float sacc = 0.f; u32x4* o8 = (u32x4*)(x2h + (size_t)m * DM) + lane;
#pragma unroll
                for (int j = 0; j < 2; ++j) { const h16x8 a = __builtin_bit_cast(h16x8, xa[q][j]), b = __builtin_bit_cast(h16x8, ya[q][j]), c = __builtin_bit_cast(h16x8, yb[q][j]);
                    float w[8];
#pragma unroll
                    for (int e = 0; e < 8; ++e) { w[e] = (float)a[e] + ((float)b[e] + (float)c[e]); sacc += w[e] * w[e]; }
                    u32x4 o; o.x = pk2(w[0], w[1]); o.y = pk2(w[2], w[3]); o.z = pk2(w[4], w[5]); o.w = pk2(w[6], w[7]); o8[64 * j] = o; }
                sacc = wave_sum(sacc); if (lane == 0) rowss3[m] = sacc; }
        }
    }
    SEAM(7);
    if (IN(8)) {
        g8::ProbDense P{(const char*)x2h, (const char*)Wpg_t, DM}; g8::StaticOrder S; S.init(T, DM, G, bx);
        g8::EpiPle E{x2h, x3h, pproj, rowss3, xss3};
        g8::gemm_phase<g8::ProbDense, g8::EpiPle, g8::StaticOrder, true>(lds, P, S, E);
    }
    SEAM(8);
    if (IN(9)) {
        for (int m0 = gw * 4; m0 < T; m0 += NGW * 4) {
            u32x4 v[4][2]; f32x4 sv[4];
#pragma unroll
            for (int q = 0; q < 4; ++q) { const u32x4* xr = (const u32x4*)(x3h + (size_t)(m0 + q) * DM) + lane;
#pragma unroll
                for (int j = 0; j < 2; ++j) v[q][j] = xr[64 * j];
                sv[q] = ((const f32x4*)(xss3 + (size_t)(m0 + q) * 16))[lane & 3]; }
            f32x4 gfv[2][2];
#pragma unroll
            for (int j = 0; j < 2; ++j) { gfv[j][0] = ((const f32x4*)g_fin)[128 * j + 2 * lane]; gfv[j][1] = ((const f32x4*)g_fin)[128 * j + 2 * lane + 1]; }
#pragma unroll
            for (int q = 0; q < 4; ++q) { float ssum = (sv[q][0] + sv[q][1]) + (sv[q][2] + sv[q][3]); ssum += __shfl_xor(ssum, 1); ssum += __shfl_xor(ssum, 2);
                const float r4 = rsqrtf(ssum * (1.f / 1024.f) + EPS);
                f32x4* orow = (f32x4*)(out + (size_t)(m0 + q) * DM);
#pragma unroll
                for (int j = 0; j < 2; ++j) { const h16x8 a = __builtin_bit_cast(h16x8, v[q][j]);
                    f32x4 o0, o1;
#pragma unroll
                    for (int e = 0; e < 4; ++e) { o0[e] = (float)a[e] * r4 * gfv[j][0][e]; o1[e] = (float)a[4 + e] * r4 * gfv[j][1][e]; }
                    orow[128 * j + 2 * lane] = o0; orow[128 * j + 2 * lane + 1] = o1; } }
        }
    }
    if (MK_STAMP >= 0 && blockIdx.x == 0 && threadIdx.x < 64) {
        const int lane = threadIdx.x;
        if (lane == 0) stamps[NPH] = __builtin_amdgcn_s_memrealtime();
        LDS_WAIT(); VM_WAIT();
        const int ka = MK_STAMP >= 0 ? MK_STAMP % 100 : 0, kb = MK_STAMP >= 0 ? MK_STAMP / 100 : 0;
        const int kend = (kb >= ka ? kb : ka) + 1;
        const float tA = (float)(stamps[kend] - stamps[ka]) * 0.01f;
        if (lane == 0) out[0] += 1.f + tA * 0.01f;
    }
#undef IN
#undef SEAM
}

extern "C" void kernel_launch(void* const* d_in, const int* in_sizes, int n_in, void* d_out, int out_size, void* d_ws, size_t ws_size, hipStream_t stream) {
    static int grid = 0;
    if (grid == 0) {
        if (n_in != 20 || in_sizes[0] != T * DM || out_size != T * DM || ws_size < WS_END) { fprintf(stderr, "kernel_launch: unexpected shapes / workspace (n_in %d, ws %zu < %zu); nothing launched\n", n_in, ws_size, (size_t)WS_END); grid = -1; return; }
        int dev = 0, cus = 0, per_cu = 0;
        if (hipGetDevice(&dev) != hipSuccess || hipDeviceGetAttribute(&cus, hipDeviceAttributeMultiprocessorCount, dev) != hipSuccess) { grid = -1; return; }
        if (hipFuncSetAttribute((const void*)mk_fwd, hipFuncAttributeMaxDynamicSharedMemorySize, LDS_BYTES) != hipSuccess) { fprintf(stderr, "kernel_launch: hipFuncSetAttribute failed\n"); grid = -1; return; }
        if (hipOccupancyMaxActiveBlocksPerMultiprocessor(&per_cu, (const void*)mk_fwd, NWAVES * 64, LDS_BYTES) != hipSuccess || per_cu < 1) { fprintf(stderr, "kernel_launch: occupancy query says %d blocks per CU\n", per_cu); }
        (void)hipGetLastError();
        grid = cus;
    }
    if (grid < 0) return;
    (void)hipMemsetAsync((char*)d_ws + WS_CTL, 0, CTL_ZERO_BYTES, stream);
    Args a{};
    for (int i = 0; i < 20; ++i) a.in[i] = (const float*)d_in[i];
    a.out = (float*)d_out; a.ws = (unsigned char*)d_ws;
#if MK_N_LAUNCHES == 1
    a.ph_lo = 0; a.ph_hi = NPH; a.li = 0;
    hipLaunchKernelGGL(mk_fwd, dim3(grid), dim3(NWAVES * 64), LDS_BYTES, stream, a);
#else
    for (int ph = 0; ph < NPH; ++ph) { a.ph_lo = ph; a.ph_hi = ph + 1; a.li = 0;
        hipLaunchKernelGGL(mk_fwd, dim3(grid), dim3(NWAVES * 64), LDS_BYTES, stream, a); }
#endif
}
```
